# Optimizing an MI355X kernel written in HIP

```python
import jax
import jax.numpy as jnp
from jax import lax
import numpy as np

D_MODEL = 1024
BATCH = 8
SEQ = 2048
DEPTH = 2

CHUNK = 64
MIX_WIDTH = D_MODEL
M_WIDTH = MIX_WIDTH // 2
M_HEADS = 4
M_HD = M_WIDTH // M_HEADS
M_CONV = 4
R_WIDTH = MIX_WIDTH - M_WIDTH
R_HD = 64
R_HEADS = R_WIDTH // R_HD
R_DECAY_LR = 64
R_A_LR = 64
R_G_LR = 128
M_SIZES = (M_WIDTH, M_WIDTH, M_WIDTH, M_WIDTH, M_HEADS, M_HEADS)
R_SIZES = (R_WIDTH, R_WIDTH, R_WIDTH, R_DECAY_LR, R_A_LR, R_G_LR)
M_COLS = sum(M_SIZES)
R_COLS = sum(R_SIZES)
IN_COLS = M_COLS + R_COLS
X_HEADS = 4
X_HD = D_MODEL // X_HEADS
N_MEM = 256
N_EXPERTS = 32
TOP_K = 4
D_FF = D_MODEL
SWIGLU_LIMIT = 7.0
SWIGLU_ALPHA = 1.702
MOE_BLOCK = 128
LN_EPS = 1e-5
HEAD_NORM_EPS = 1e-5
RWKV_GN_EPS = 64e-5
DN_ALPHA = (2 * DEPTH) ** 0.25
DN_BETA = (8 * DEPTH) ** -0.25

kernel_name = 'hybrid_mlstm_rwkv7_moe_encoder'


def split_cols(p, sizes):
    cuts = [int(c) for c in np.cumsum(sizes)[:-1]]
    return jnp.split(p, cuts, axis=-1)


def layer_norm(x, g, b):
    xf = x.astype(jnp.float32)
    mu = jnp.mean(xf, axis=-1, keepdims=True)
    var = jnp.mean(jnp.square(xf - mu), axis=-1, keepdims=True)
    y = (xf - mu) * lax.rsqrt(var + LN_EPS) * g.astype(jnp.float32) + b.astype(jnp.float32)
    return y.astype(x.dtype)


def head_standardize(x, eps):
    mu = jnp.mean(x, axis=-1, keepdims=True)
    var = jnp.mean(jnp.square(x - mu), axis=-1, keepdims=True)
    return (x - mu) * lax.rsqrt(var + eps)


def causal_dwconv(x, w, b):
    k_w, c = w.shape
    y = lax.conv_general_dilated(x, w[:, None, :].astype(x.dtype), window_strides=(1,),
                                 padding=[(k_w - 1, 0)],
                                 dimension_numbers=('NWC', 'WIO', 'NWC'),
                                 feature_group_count=c)
    return y + b


def token_shift(p, mu):
    prev = jnp.pad(p, ((0, 0), (1, 0), (0, 0)))[:, :-1]
    return p + (prev - p) * mu


def mlstm_chunkwise(q, k, v, i_pre, f_pre):
    f32 = jnp.float32
    B, S, H, D = q.shape
    NC = S // CHUNK
    blk = lambda t: t.astype(f32).reshape(B, NC, CHUNK, H, D).transpose(0, 3, 1, 2, 4)
    gblk = lambda t: t.astype(f32).reshape(B, NC, CHUNK, H).transpose(0, 3, 1, 2)
    q, k, v = blk(q), blk(k) * (D ** -0.5), blk(v)
    ig = gblk(i_pre)
    b = jnp.cumsum(jax.nn.log_sigmoid(gblk(f_pre)), axis=-1)
    b_last = b[..., -1]
    src = b_last[..., None] - b + ig
    m_loc = jnp.max(src, axis=-1)
    w_src = jnp.exp(src - m_loc[..., None])
    C_loc = jnp.einsum('bhcsv,bhcsk->bhcvk', v * w_src[..., None], k)
    n_loc = jnp.einsum('bhcs,bhcsk->bhck', w_src, k)

    def step(carry, inp):
        C, n, m = carry
        C_l, n_l, m_l, bl = inp
        m_new = jnp.maximum(bl + m, m_l)
        a = jnp.exp(bl + m - m_new)
        c = jnp.exp(m_l - m_new)
        C_new = a[..., None, None] * C + c[..., None, None] * C_l
        n_new = a[..., None] * n + c[..., None] * n_l
        return (C_new, n_new, m_new), (C, n, m)

    init = (jnp.zeros((B, H, D, D), f32), jnp.zeros((B, H, D), f32), jnp.zeros((B, H), f32))
    xs = (jnp.moveaxis(C_loc, 2, 0), jnp.moveaxis(n_loc, 2, 0),
          jnp.moveaxis(m_loc, 2, 0), jnp.moveaxis(b_last, 2, 0))
    _, (C_prev, n_prev, m_prev) = lax.scan(step, init, xs)
    C_prev = jnp.moveaxis(C_prev, 0, 2)
    n_prev = jnp.moveaxis(n_prev, 0, 2)
    m_prev = jnp.moveaxis(m_prev, 0, 2)

    g_inter = b + m_prev[..., None]
    causal = jnp.tril(jnp.ones((CHUNK, CHUNK), dtype=bool))
    d_mat = jnp.where(causal, b[..., :, None] - b[..., None, :] + ig[..., None, :], -jnp.inf)
    m_t = jnp.maximum(g_inter, jnp.max(d_mat, axis=-1))
    s = jnp.einsum('bhctd,bhcsd->bhcts', q, k) * jnp.exp(d_mat - m_t[..., None])
    w_inter = jnp.exp(g_inter - m_t)
    num = jnp.einsum('bhcts,bhcsv->bhctv', s, v) + w_inter[..., None] * jnp.einsum('bhcvk,bhctk->bhctv', C_prev, q)
    den = jnp.sum(s, axis=-1) + w_inter * jnp.einsum('bhck,bhctk->bhct', n_prev, q)
    h = num / jnp.maximum(jnp.abs(den), jnp.exp(-m_t))[..., None]
    return h.transpose(0, 2, 3, 1, 4).reshape(B, S, H, D)


def rwkv7_scan(r, w_log, k, v, kk, a):
    f32 = jnp.float32
    B, S, H, D = r.shape
    decay = jnp.exp(-jnp.exp(w_log.astype(f32)))

    def step(state, inp):
        r_t, d_t, k_t, v_t, kk_t, a_t = inp
        sa = jnp.einsum('bhvk,bhk->bhv', state, -kk_t)
        state = (state * d_t[:, :, None, :] + sa[..., None] * (kk_t * a_t)[:, :, None, :]
                 + v_t[..., None] * k_t[:, :, None, :])
        y = jnp.einsum('bhvk,bhk->bhv', state, r_t)
        return state, y

    xs = tuple(t.astype(f32).transpose(1, 0, 2, 3) for t in (r, decay, k, v, kk, a))
    _, y = lax.scan(step, jnp.zeros((B, H, D, D), f32), xs)
    return y.transpose(1, 0, 2, 3)


def hybrid_mixer(h, w_in, m_conv_w, m_conv_b, m_ig_b, m_fg_b, m_norm_g, r_mu, r_w0, r_w2,
                 r_a0, r_a2, r_g2, r_kk, r_ka, r_rk, r_gn_g, r_gn_b, w_out):
    f32 = jnp.float32
    B, S, _ = h.shape
    proj = h @ w_in
    m_cols, r_cols = proj[..., :M_COLS], proj[..., M_COLS:]

    mq, mk, mv, mo, mi, mf = split_cols(m_cols, M_SIZES)
    qk = jax.nn.silu(causal_dwconv(jnp.concatenate([mq, mk], axis=-1), m_conv_w, m_conv_b))
    mq, mk = qk[..., :M_WIDTH], qk[..., M_WIDTH:]
    hm = mlstm_chunkwise(mq.reshape(B, S, M_HEADS, M_HD), mk.reshape(B, S, M_HEADS, M_HD),
                         mv.reshape(B, S, M_HEADS, M_HD), mi + m_ig_b, mf + m_fg_b)
    hm = head_standardize(hm, HEAD_NORM_EPS).reshape(B, S, M_WIDTH) * m_norm_g
    hm = hm * jax.nn.sigmoid(mo.astype(f32))

    rr, rk, rv, rwl, ral, rgl = split_cols(token_shift(r_cols, r_mu).astype(f32), R_SIZES)
    w_log = -jax.nn.softplus(-(r_w0 + jnp.tanh(rwl) @ r_w2)) - 0.5
    a = jax.nn.sigmoid(r_a0 + ral @ r_a2)
    g = jax.nn.sigmoid(rgl) @ r_g2
    kk = (rk * r_kk).reshape(B, S, R_HEADS, R_HD)
    kk = kk / jnp.maximum(jnp.sqrt(jnp.sum(jnp.square(kk), axis=-1, keepdims=True)), 1e-12)
    rk = rk * (1.0 + (a - 1.0) * r_ka)
    r4, k4, v4, a4, w4 = [t.reshape(B, S, R_HEADS, R_HD) for t in (rr, rk, rv, a, w_log)]
    y = rwkv7_scan(r4, w4, k4, v4, kk, a4)
    y = head_standardize(y, RWKV_GN_EPS).reshape(B, S, R_WIDTH) * r_gn_g + r_gn_b
    bonus = jnp.sum(r4 * k4 * r_rk.reshape(R_HEADS, R_HD), axis=-1, keepdims=True) * v4
    hr = (y + bonus.reshape(B, S, R_WIDTH)) * g

    mixed = jnp.concatenate([hm, hr], axis=-1).astype(h.dtype)
    return mixed @ w_out


def cross_attention(h, mem, wq, wkv, wo):
    B, S, _ = h.shape
    M = mem.shape[1]
    q = (h @ wq).reshape(B, S, X_HEADS, X_HD)
    kv = (mem @ wkv).reshape(B, M, 2, X_HEADS, X_HD)
    k, v = kv[:, :, 0], kv[:, :, 1]
    s = jnp.einsum('bshd,bmhd->bhsm', q, k).astype(jnp.float32) * (X_HD ** -0.5)
    p = jax.nn.softmax(s, axis=-1).astype(h.dtype)
    o = jnp.einsum('bhsm,bmhd->bshd', p, v).reshape(B, S, X_HEADS * X_HD)
    return o @ wo


def moe_ffn(h, wr, br, w1, b1, w2, b2):
    B, S, Dm = h.shape
    xt = h.reshape(-1, Dm)
    N = xt.shape[0]
    logits = (xt @ wr).astype(jnp.float32) + br.astype(jnp.float32)
    top_v, top_i = lax.top_k(logits, TOP_K)
    gates = jax.nn.softmax(top_v, axis=-1)
    n_assign = N * TOP_K
    e_flat = top_i.reshape(-1)
    tok_flat = jnp.arange(n_assign) // TOP_K
    order = jnp.argsort(e_flat)
    e_sorted = e_flat[order]
    tok_sorted = tok_flat[order]
    gate_sorted = gates.reshape(-1)[order]
    counts = jnp.bincount(e_flat, length=N_EXPERTS)
    start = jnp.cumsum(counts) - counts
    padded = (counts + MOE_BLOCK - 1) // MOE_BLOCK * MOE_BLOCK
    pad_end = jnp.cumsum(padded)
    pad_start = pad_end - padded
    dest = pad_start[e_sorted] + (jnp.arange(n_assign) - start[e_sorted])
    n_rows = ((n_assign + MOE_BLOCK - 1) // MOE_BLOCK + N_EXPERTS) * MOE_BLOCK
    n_blocks = n_rows // MOE_BLOCK
    buf = jnp.zeros((n_rows, Dm), h.dtype).at[dest].set(xt[tok_sorted])
    block_e = jnp.minimum(jnp.searchsorted(pad_end, jnp.arange(n_blocks) * MOE_BLOCK, side='right'),
                          N_EXPERTS - 1)

    def expert_block(args):
        xb, e = args
        hu = xb @ w1[e] + b1[e]
        gate, up = hu[:, :D_FF], hu[:, D_FF:]
        gate = jnp.minimum(gate, SWIGLU_LIMIT)
        up = jnp.clip(up, -SWIGLU_LIMIT, SWIGLU_LIMIT)
        glu = gate * jax.nn.sigmoid(gate * SWIGLU_ALPHA)
        return ((up + 1.0) * glu) @ w2[e] + b2[e]

    y_buf = lax.map(expert_block, (buf.reshape(n_blocks, MOE_BLOCK, Dm), block_e)).reshape(n_rows, Dm)
    y = y_buf[dest] * gate_sorted[:, None].astype(y_buf.dtype)
    out = jnp.zeros((N, Dm), y.dtype).at[tok_sorted].add(y)
    return out.reshape(B, S, Dm).astype(h.dtype)


def setup_inputs(seed: int = 0) -> dict:
    key = jax.random.key(seed)
    ks = iter(jax.random.split(key, 64))
    f32 = jnp.float32
    L = DEPTH

    def nrm(shape, scale):
        return jax.random.normal(next(ks), shape, f32) * scale

    return {
        'x': nrm((BATCH, SEQ, D_MODEL), 1.0),
        'mem': nrm((BATCH, N_MEM, D_MODEL), 1.0),
        'ln0_g': 1.0 + nrm((D_MODEL,), 0.02),
        'ln0_b': nrm((D_MODEL,), 0.02),
        'w_in': nrm((L, D_MODEL, IN_COLS), D_MODEL ** -0.5),
        'm_conv_w': nrm((L, M_CONV, 2 * M_WIDTH), M_CONV ** -0.5),
        'm_conv_b': nrm((L, 2 * M_WIDTH), 0.02),
        'm_ig_b': nrm((L, M_HEADS), 0.1),
        'm_fg_b': jnp.linspace(3.0, 6.0, M_HEADS, dtype=f32)[None] + nrm((L, M_HEADS), 0.1),
        'm_norm_g': 1.0 + nrm((L, M_WIDTH), 0.02),
        'r_mu': jax.random.uniform(next(ks), (L, R_COLS), f32),
        'r_w0': jnp.linspace(-6.0, -1.0, R_WIDTH, dtype=f32)[None] + nrm((L, R_WIDTH), 0.1),
        'r_w2': nrm((L, R_DECAY_LR, R_WIDTH), 0.1),
        'r_a0': nrm((L, R_WIDTH), 0.1),
        'r_a2': nrm((L, R_A_LR, R_WIDTH), R_A_LR ** -0.5),
        'r_g2': nrm((L, R_G_LR, R_WIDTH), R_G_LR ** -0.5),
        'r_kk': 0.85 + nrm((L, R_WIDTH), 0.05),
        'r_ka': 1.0 + nrm((L, R_WIDTH), 0.05),
        'r_rk': nrm((L, R_WIDTH), 0.1),
        'r_gn_g': 1.0 + nrm((L, R_WIDTH), 0.02),
        'r_gn_b': nrm((L, R_WIDTH), 0.02),
        'w_out': nrm((L, MIX_WIDTH, D_MODEL), MIX_WIDTH ** -0.5 * DN_BETA),
        'ln1_g': 1.0 + nrm((L, D_MODEL), 0.02),
        'ln1_b': nrm((L, D_MODEL), 0.02),
        'x_wq': nrm((L, D_MODEL, D_MODEL), D_MODEL ** -0.5),
        'x_wkv': nrm((L, D_MODEL, 2 * D_MODEL), D_MODEL ** -0.5),
        'x_wo': nrm((L, D_MODEL, D_MODEL), D_MODEL ** -0.5 * DN_BETA),
        'ln2_g': 1.0 + nrm((L, D_MODEL), 0.02),
        'ln2_b': nrm((L, D_MODEL), 0.02),
        'moe_wr': nrm((L, D_MODEL, N_EXPERTS), D_MODEL ** -0.5),
        'moe_br': nrm((L, N_EXPERTS), 0.01),
        'moe_w1': nrm((L, N_EXPERTS, D_MODEL, 2 * D_FF), D_MODEL ** -0.5),
        'moe_b1': nrm((L, N_EXPERTS, 2 * D_FF), 0.01),
        'moe_w2': nrm((L, N_EXPERTS, D_FF, D_MODEL), D_FF ** -0.5 * DN_BETA),
        'moe_b2': nrm((L, N_EXPERTS, D_MODEL), 0.01),
        'ln3_g': 1.0 + nrm((L, D_MODEL), 0.02),
        'ln3_b': nrm((L, D_MODEL), 0.02),
    }


def reference(x, mem, ln0_g, ln0_b, w_in, m_conv_w, m_conv_b, m_ig_b, m_fg_b, m_norm_g,
              r_mu, r_w0, r_w2, r_a0, r_a2, r_g2, r_kk, r_ka, r_rk, r_gn_g, r_gn_b, w_out,
              ln1_g, ln1_b, x_wq, x_wkv, x_wo, ln2_g, ln2_b, moe_wr, moe_br, moe_w1, moe_b1,
              moe_w2, moe_b2, ln3_g, ln3_b):
    h = layer_norm(x, ln0_g, ln0_b)
    for l in range(DEPTH):
        mix = hybrid_mixer(h, w_in[l], m_conv_w[l], m_conv_b[l], m_ig_b[l], m_fg_b[l], m_norm_g[l],
                           r_mu[l], r_w0[l], r_w2[l], r_a0[l], r_a2[l], r_g2[l], r_kk[l], r_ka[l],
                           r_rk[l], r_gn_g[l], r_gn_b[l], w_out[l])
        h = layer_norm(DN_ALPHA * h + mix, ln1_g[l], ln1_b[l])
        h = layer_norm(DN_ALPHA * h + cross_attention(h, mem, x_wq[l], x_wkv[l], x_wo[l]),
                       ln2_g[l], ln2_b[l])
        h = layer_norm(DN_ALPHA * h + moe_ffn(h, moe_wr[l], moe_br[l], moe_w1[l], moe_b1[l],
                                              moe_w2[l], moe_b2[l]),
                       ln3_g[l], ln3_b[l])
    return h
```

```cpp
#include <hip/hip_runtime.h>
#include <hip/hip_cooperative_groups.h>
#include <cstdio>
#include <cstdint>
namespace cg = cooperative_groups;

#ifndef ONE_LAUNCH
#define ONE_LAUNCH 1
#endif

#define LAS __attribute__((address_space(3)))
typedef unsigned short bf16_t;
typedef short bf16x8 __attribute__((ext_vector_type(8)));
typedef float f32x4 __attribute__((ext_vector_type(4)));
typedef float f32x2 __attribute__((ext_vector_type(2)));
typedef unsigned u32x4 __attribute__((ext_vector_type(4)));
typedef unsigned u32x2 __attribute__((ext_vector_type(2)));

constexpr int T_TOK = 16384, DM = 1024, SEQ = 2048, NBATCH = 8, DEPTH = 2;
constexpr int IN_COLS = 3848, NPROJ = 4096;
constexpr int RC0 = 2048;
constexpr int NEXP = 32, NMEM = 256;
constexpr int MOE_ROWS = 65536 + NEXP * 256;
constexpr int RECF = 388;
constexpr float DN_ALPHA = 1.4142135623730951f;
constexpr int NTHREADS = 512, NWAVES = 8;
constexpr int LDS_BYTES = 147456;
constexpr int GEMM_LDS = 131072;
constexpr int MISC_OFF = GEMM_LDS;

constexpr size_t MiB = 1u << 20;
constexpr size_t WS_CTL = 0;
constexpr size_t CTL_BYTES = 65536;
constexpr size_t WS_WIN = 1 * MiB;
constexpr size_t WS_WOUT = WS_WIN + 16 * MiB;
constexpr size_t WS_WQ = WS_WOUT + 4 * MiB;
constexpr size_t WS_WKV = WS_WQ + 4 * MiB;
constexpr size_t WS_WO = WS_WKV + 8 * MiB;
constexpr size_t WS_WLR = WS_WO + 4 * MiB;
constexpr size_t WS_W1 = WS_WLR + 2 * MiB;
constexpr size_t WS_W2 = WS_W1 + 256 * MiB;
constexpr size_t WS_H = WS_W2 + 128 * MiB;
constexpr size_t WS_HB = WS_H + 64 * MiB;
constexpr size_t WS_MEMB = WS_HB + 32 * MiB;
constexpr size_t WS_KBUF = WS_MEMB + 4 * MiB;
constexpr size_t WS_VTB = WS_KBUF + 8 * MiB;
constexpr size_t WS_CF = WS_VTB + 8 * MiB;
constexpr size_t WS_MIXED = WS_CF + 64 * MiB;
constexpr size_t WS_QB = WS_MIXED + 32 * MiB;
constexpr size_t WS_PB = WS_QB + 32 * MiB;
constexpr size_t WS_OB = WS_PB + 32 * MiB;
constexpr size_t WS_SMALL = WS_OB + 32 * MiB;
constexpr size_t SM_GATES = WS_SMALL;
constexpr size_t SM_BCUM = SM_GATES + 512 * 1024;
constexpr size_t SM_IGA = SM_BCUM + 256 * 1024;
constexpr size_t SM_BON = SM_IGA + 256 * 1024;
constexpr size_t SM_TOPI = SM_BON + 512 * 1024;
constexpr size_t SM_TOPG = SM_TOPI + 256 * 1024;
constexpr size_t SM_SLOT = SM_TOPG + 256 * 1024;
constexpr size_t SM_MLOC = SM_SLOT + 256 * 1024;
constexpr size_t SM_BLAST = SM_MLOC + 4096;
constexpr size_t SM_MPREV = SM_BLAST + 4096;
constexpr size_t SM_NLOC = SM_MPREV + 4096;
constexpr size_t WS_UNION = WS_SMALL + 8 * MiB;
constexpr size_t WS_PROJ = WS_UNION;
constexpr size_t WS_XLR = WS_PROJ + 128 * MiB;
constexpr size_t WS_LR = WS_XLR + 8 * MiB;
constexpr size_t WS_REC = WS_LR + 96 * MiB;
constexpr size_t WS_GV = WS_REC + 196 * MiB;
constexpr size_t WS_YR = WS_GV + 32 * MiB;
constexpr size_t WS_QC = WS_YR + 32 * MiB;
constexpr size_t WS_KC = WS_QC + 16 * MiB;
constexpr size_t WS_CLOC = WS_KC + 16 * MiB;
constexpr size_t WS_CPREV = WS_CLOC + 64 * MiB;
constexpr size_t WS_MIXEND = WS_CPREV + 36 * MiB;
constexpr size_t WS_XG = WS_UNION;
constexpr size_t WS_GACT = WS_XG + 144 * MiB;
constexpr size_t WS_YB = WS_GACT + 144 * MiB;
constexpr size_t WS_END = WS_MIXEND;
static_assert(WS_YB + 144 * MiB <= WS_MIXEND, "moe overlay fits");
static_assert((size_t)64 * 2048 * RECF * 4 <= 196 * MiB, "rec fits");
constexpr int CW_CNT = 0;
constexpr int CW_CUR = 64;
constexpr int CW_TILE = 128;

__device__ __forceinline__ unsigned f2bf(float f) { unsigned u = __builtin_bit_cast(unsigned, f); return (u + 0x7fffu + ((u >> 16) & 1u)) >> 16; }
__device__ __forceinline__ unsigned pk2(float lo, float hi) { return f2bf(lo) | (f2bf(hi) << 16); }
__device__ __forceinline__ float bf2f(unsigned b) { return __builtin_bit_cast(float, b << 16); }
__device__ __forceinline__ float bflo(unsigned w) { return __builtin_bit_cast(float, w << 16); }
__device__ __forceinline__ float bfhi(unsigned w) { return __builtin_bit_cast(float, w & 0xffff0000u); }
__device__ __forceinline__ unsigned cvt_pk_bf16(float lo, float hi) { unsigned r; asm volatile("v_cvt_pk_bf16_f32 %0, %1, %2" : "=v"(r) : "v"(lo), "v"(hi)); return r; }
__device__ __forceinline__ float wave_sum(float v) {
#pragma unroll
    for (int o = 1; o < 64; o <<= 1) v += __shfl_xor(v, o);
    return v;
}
__device__ __forceinline__ float wave_max(float v) {
#pragma unroll
    for (int o = 1; o < 64; o <<= 1) v = fmaxf(v, __shfl_xor(v, o));
    return v;
}
__device__ __forceinline__ float sigmoidf_(float x) { return 1.0f / (1.0f + __expf(-x)); }
__device__ __forceinline__ float softplusf_(float x) { return fmaxf(x, 0.f) + log1pf(__expf(-fabsf(x))); }
#define LDS_WAIT() asm volatile("s_waitcnt lgkmcnt(0)" ::: "memory")

namespace pg8 {
constexpr int BM = 256, BK = 64, HALF = 128, HTB = HALF * BK * 2, NXCD = 8, WGM = 8;
__device__ __forceinline__ int lds_byte(int r, int c) { const int st = (r >> 4) * 2 + (c >> 5), rr = r & 15, cc = c & 31, ob = rr * 64 + cc * 2; return st * 1024 + (ob ^ (((ob >> 9) & 1) << 5)); }
__device__ __forceinline__ void stage_rc(int b, int& R, int& C) { const int st = b / 1024, sb = b % 1024, swz = sb ^ (((sb >> 9) & 1) << 5); R = (st >> 1) * 16 + swz / 64; C = (st & 1) * 32 + (swz % 64) / 2; }
__device__ __forceinline__ int perm32(int rho) { const int n = rho >> 4, i = rho & 15; return 8 * (i >> 2) + 4 * n + (i & 3); }

struct Unit { int pm, pn, e; };

template <class Epi, class Sched>
__device__ __forceinline__ void gemm_phase(LAS unsigned char* lds, const Sched& S, const Epi& E) {
    int tid_ = threadIdx.x; asm volatile("" : "+v"(tid_)); const int tid = tid_, wid = __builtin_amdgcn_readfirstlane(tid >> 6), lane = tid & 63, wr = wid >> 2, wc = wid & 3, fr = lane & 15, fq = lane >> 4;
    const int K = S.K, nt = K / BK;
    unsigned voffA[2], voffB[2];
#pragma unroll
    for (int i = 0; i < 2; ++i) { int R, C; stage_rc(tid * 16 + i * 8192, R, C); const int Rb = Epi::PERM ? ((R & ~31) + perm32(R & 31)) : R;
        voffA[i] = (unsigned)(R * S.lda + C) * 2u; voffB[i] = (unsigned)(Rb * S.ldb + C) * 2u; }
    const size_t kstep = (size_t)(BK * 2);
    const size_t hstepA = (size_t)HALF * S.lda * 2, hstepB = (size_t)HALF * S.ldb * 2;
    const unsigned ldsw = (unsigned)wid * 1024u;
    const int aoff = lds_byte(wr * 64 + fr, fq * 8), boff = lds_byte(wc * 32 + fr, fq * 8);
#define PG8_SA(b, h) (((b) * 2 + (h)) * HTB)
#define PG8_SB(b, h) ((4 + (b) * 2 + (h)) * HTB)
#define PG8_STAGE(bufoff, gbase, voff) do { _Pragma("unroll") for (int _i = 0; _i < 2; ++_i) \
        __builtin_amdgcn_global_load_lds((const unsigned*)((const char*)(gbase) + (voff)[_i]), (LAS unsigned*)(lds + (bufoff) + ldsw + _i * 8192), 16, 0, 0); } while (0)
#define PG8_LDA(dst, b, h) do { _Pragma("unroll") for (int m = 0; m < 4; ++m) _Pragma("unroll") for (int k = 0; k < 2; ++k) dst[m][k] = *(const LAS bf16x8*)(lds + PG8_SA(b, h) + aoff + m * 2048 + k * 1024); } while (0)
#define PG8_LDB(dst, b, h) do { _Pragma("unroll") for (int n = 0; n < 2; ++n) _Pragma("unroll") for (int k = 0; k < 2; ++k) dst[n][k] = *(const LAS bf16x8*)(lds + PG8_SB(b, h) + boff + n * 2048 + k * 1024); } while (0)
#define PG8_MMA(ai, bj, At, Bt) do { __builtin_amdgcn_s_setprio(1); _Pragma("unroll") for (int m = 0; m < 4; ++m) _Pragma("unroll") for (int n = 0; n < 2; ++n) _Pragma("unroll") for (int k = 0; k < 2; ++k) \
        acc[ai][bj][m][n] = __builtin_amdgcn_mfma_f32_16x16x32_bf16(Bt[n][k], At[m][k], acc[ai][bj][m][n], 0, 0, 0); __builtin_amdgcn_s_setprio(0); } while (0)
#define PG8_WAIT_V(n) asm volatile("s_waitcnt vmcnt(" #n ")" ::: "memory")
#define PG8_WAIT_L(n) asm volatile("s_waitcnt lgkmcnt(" #n ")" ::: "memory")
#define PG8_BAR __builtin_amdgcn_s_barrier()
#define PG8_SCHED __builtin_amdgcn_sched_barrier(0)
    Unit cur, nxt; int ui = 0;
    if (!S.next(0, cur)) return;
    f32x4 acc[2][2][4][2];
#pragma unroll
    for (int a = 0; a < 2; ++a)
#pragma unroll
        for (int b = 0; b < 2; ++b)
#pragma unroll
            for (int m = 0; m < 4; ++m)
#pragma unroll
                for (int n = 0; n < 2; ++n) acc[a][b][m][n] = (f32x4){0.f, 0.f, 0.f, 0.f};
    bf16x8 At[4][2], B0[2][2], B1[2][2];
    const char* cA = S.aptr(cur); const char* cB = S.bptr(cur);
    PG8_STAGE(PG8_SB(0, 0), cB, voffB); PG8_STAGE(PG8_SA(0, 0), cA, voffA); PG8_STAGE(PG8_SB(0, 1), cB + hstepB, voffB); PG8_STAGE(PG8_SA(0, 1), cA + hstepA, voffA);
    if (wr == 1) PG8_BAR;
    PG8_WAIT_V(4); PG8_BAR;
    PG8_STAGE(PG8_SB(1, 0), cB + kstep, voffB); PG8_STAGE(PG8_SA(1, 0), cA + kstep, voffA); PG8_STAGE(PG8_SB(1, 1), cB + hstepB + kstep, voffB);
    PG8_WAIT_V(6); PG8_BAR;
    for (;;) {
        const bool has_next = S.next(ui + 1, nxt);
        const char* nA = has_next ? S.aptr(nxt) : cA; const char* nB = has_next ? S.bptr(nxt) : cB;
        for (int t = 0; t < nt; t += 2) {
            const bool last = (t == nt - 2);
            const char* a1 = cA + (size_t)(t + 1) * kstep;
            const char* a2 = last ? nA : cA + (size_t)(t + 2) * kstep; const char* b2 = last ? nB : cB + (size_t)(t + 2) * kstep;
            const char* a3 = a2 + kstep; const char* b3 = b2 + kstep;
            PG8_LDB(B0, 0, 0); PG8_SCHED; PG8_LDA(At, 0, 0); PG8_STAGE(PG8_SA(1, 1), a1 + hstepA, voffA);
            PG8_WAIT_L(8); PG8_BAR; PG8_WAIT_L(0); PG8_MMA(0, 0, At, B0); PG8_BAR; PG8_SCHED;
            PG8_LDB(B1, 0, 1); PG8_STAGE(PG8_SB(0, 0), b2, voffB);
            PG8_BAR; PG8_WAIT_L(0); PG8_MMA(0, 1, At, B1); PG8_BAR;
            PG8_LDA(At, 0, 1); PG8_STAGE(PG8_SA(0, 0), a2, voffA);
            PG8_BAR; PG8_WAIT_L(0); PG8_MMA(1, 0, At, B0); PG8_BAR; PG8_SCHED;
            PG8_STAGE(PG8_SB(0, 1), b2 + hstepB, voffB);
            PG8_WAIT_V(6); PG8_BAR; PG8_MMA(1, 1, At, B1); PG8_BAR;
            PG8_LDB(B0, 1, 0); PG8_SCHED; PG8_LDA(At, 1, 0); PG8_STAGE(PG8_SA(0, 1), a2 + hstepA, voffA);
            PG8_WAIT_L(8); PG8_BAR; PG8_WAIT_L(0); PG8_MMA(0, 0, At, B0); PG8_BAR; PG8_SCHED;
            PG8_LDB(B1, 1, 1); PG8_STAGE(PG8_SB(1, 0), b3, voffB);
            PG8_BAR; PG8_WAIT_L(0); PG8_MMA(0, 1, At, B1); PG8_BAR;
            PG8_LDA(At, 1, 1); PG8_STAGE(PG8_SA(1, 0), a3, voffA);
            PG8_BAR; PG8_WAIT_L(0); PG8_MMA(1, 0, At, B0); PG8_BAR; PG8_SCHED;
            PG8_STAGE(PG8_SB(1, 1), b3 + hstepB, voffB);
            PG8_WAIT_V(6); PG8_BAR; PG8_MMA(1, 1, At, B1); PG8_BAR;
        }
        if constexpr (!Epi::AFTER_DRAIN) { int fr_ = fr, fq_ = fq; asm volatile("" : "+v"(fr_), "+v"(fq_)); E(acc, cur, wr, wc, fr_, fq_); }
        if (!has_next) break;
#pragma unroll
        for (int a = 0; a < 2; ++a)
#pragma unroll
            for (int b = 0; b < 2; ++b)
#pragma unroll
                for (int m = 0; m < 4; ++m)
#pragma unroll
                    for (int n = 0; n < 2; ++n) acc[a][b][m][n] = (f32x4){0.f, 0.f, 0.f, 0.f};
        cur = nxt; cA = nA; cB = nB; ++ui;
    }
    PG8_WAIT_V(0);
    if (wr == 0) PG8_BAR;
    PG8_BAR;
    if constexpr (Epi::AFTER_DRAIN) { int fr_ = fr, fq_ = fq; asm volatile("" : "+v"(fr_), "+v"(fq_)); E.fused(acc, cur, wr, wc, fr_, fq_, lds, wid, lane); }
#undef PG8_SA
#undef PG8_SB
#undef PG8_STAGE
#undef PG8_LDA
#undef PG8_LDB
#undef PG8_MMA
#undef PG8_WAIT_V
#undef PG8_WAIT_L
#undef PG8_BAR
#undef PG8_SCHED
}

struct DenseOrder {
    const char* A; const char* Bt; int lda, ldb, K; int nM, nN, nwg, G, c;
    __device__ void init(const void* A_, const void* Bt_, int M, int N, int K_, int lda_, int ldb_, int G_, int c_) { A = (const char*)A_; Bt = (const char*)Bt_; K = K_; lda = lda_; ldb = ldb_; nM = M / BM; nN = N / BM; nwg = nM * nN; G = G_; c = c_; }
    __device__ bool next(int i, Unit& u) const {
        const long L = (long)i * G + c; if (L >= nwg) return false;
        int wgid = (int)L; { const int q = nwg / NXCD, r = nwg % NXCD, xcd = wgid % NXCD, off = wgid / NXCD; wgid = (xcd < r ? xcd * (q + 1) : r * (q + 1) + (xcd - r) * q) + off; }
        const int nig = WGM * nN, gid = wgid / nig, fm = gid * WGM, gsz = (nM - fm) < WGM ? (nM - fm) : WGM;
        u.pm = fm + ((wgid % nig) % gsz); u.pn = (wgid % nig) / gsz; u.e = 0; return true;
    }
    __device__ __forceinline__ const char* aptr(const Unit& u) const { return A + (size_t)u.pm * BM * lda * 2; }
    __device__ __forceinline__ const char* bptr(const Unit& u) const { return Bt + (size_t)u.pn * BM * ldb * 2; }
};
struct KvOrder {
    const char* memb; const char* wkv; int lda, ldb, K, G, c;
    __device__ bool next(int i, Unit& u) const {
        const int L = i * G + c; if (L >= 128) return false;
        const int layer = L >> 6, rem = L & 63;
        if (rem < 32) { u.pm = rem >> 2; u.pn = rem & 3; u.e = layer * 2; }
        else { u.pm = (rem - 32) >> 3; u.pn = (rem - 32) & 7; u.e = layer * 2 + 1; }
        return true;
    }
    __device__ __forceinline__ const char* aptr(const Unit& u) const {
        const int layer = u.e >> 1;
        return (u.e & 1) ? wkv + ((size_t)layer * 2048 + 1024 + (size_t)u.pm * 256) * 2048 : memb + (size_t)u.pm * 256 * 2048;
    }
    __device__ __forceinline__ const char* bptr(const Unit& u) const {
        const int layer = u.e >> 1;
        return (u.e & 1) ? memb + (size_t)u.pn * 256 * 2048 : wkv + ((size_t)layer * 2048 + (size_t)u.pn * 256) * 2048;
    }
};
struct SOrder {
    const char* Q; const char* Kb; int lda, ldb, K, G, c;
    __device__ bool next(int i, Unit& u) const { const int L = i * G + c; if (L >= 256) return false; u.pm = L & 7; u.pn = 0; u.e = L >> 3; return true; }
    __device__ __forceinline__ const char* aptr(const Unit& u) const { const int b = u.e >> 2, hd = u.e & 3; return Q + (((size_t)b * 2048 + (size_t)u.pm * 256) * 1024 + hd * 256) * 2; }
    __device__ __forceinline__ const char* bptr(const Unit& u) const { const int b = u.e >> 2, hd = u.e & 3; return Kb + (((size_t)b * 256) * 1024 + hd * 256) * 2; }
};
struct PvOrder {
    const char* P; const char* Vt; int lda, ldb, K, G, c;
    __device__ bool next(int i, Unit& u) const { const int L = i * G + c; if (L >= 256) return false; u.pm = L & 7; u.pn = 0; u.e = L >> 3; return true; }
    __device__ __forceinline__ const char* aptr(const Unit& u) const { return P + (((size_t)u.e * 2048 + (size_t)u.pm * 256) * 256) * 2; }
    __device__ __forceinline__ const char* bptr(const Unit& u) const { const int b = u.e >> 2, hd = u.e & 3; return Vt + (((size_t)hd * 256) * 2048 + (size_t)b * 256) * 2; }
};
struct MoeOrder {
    const char* A; const char* W; LAS const int* ul; size_t wstride; int lda, ldb, K;
    __device__ bool next(int i, Unit& u) const {
        if (i >= 16) return false;
        const int pm = __builtin_amdgcn_readfirstlane(ul[3 * i]); if (pm < 0) return false;
        u.pm = pm; u.pn = __builtin_amdgcn_readfirstlane(ul[3 * i + 1]); u.e = __builtin_amdgcn_readfirstlane(ul[3 * i + 2]); return true;
    }
    __device__ __forceinline__ const char* aptr(const Unit& u) const { return A + (size_t)u.pm * 256 * lda * 2; }
    __device__ __forceinline__ const char* bptr(const Unit& u) const { return W + (size_t)u.e * wstride + (size_t)u.pn * 256 * ldb * 2; }
};

struct EpiF32 {
    static constexpr bool PERM = false, AFTER_DRAIN = false;
    float* C; int ldc;
    __device__ __forceinline__ void operator()(const f32x4 (&acc)[2][2][4][2], const Unit& u, int wr, int wc, int fr, int fq) const {
        const int row0 = u.pm * BM + wr * 64 + fr, col0 = u.pn * BM + wc * 32 + 4 * fq;
#pragma unroll
        for (int ai = 0; ai < 2; ++ai)
#pragma unroll
            for (int m = 0; m < 4; ++m) { float* rowp = C + (size_t)(row0 + ai * HALF + m * 16) * ldc + col0;
#pragma unroll
                for (int bj = 0; bj < 2; ++bj)
#pragma unroll
                    for (int n = 0; n < 2; ++n) *(f32x4*)(rowp + bj * HALF + n * 16) = acc[ai][bj][m][n]; }
    }
};
__device__ __forceinline__ void store_bf16_tile(const f32x4 (&acc)[2][2][4][2], bf16_t* base, int ldc, float sc, int wr, int wc, int fr, int fq) {
    const int row0 = wr * 64 + fr, col0 = wc * 32 + 8 * fq;
#pragma unroll
    for (int ai = 0; ai < 2; ++ai)
#pragma unroll
        for (int m = 0; m < 4; ++m) { bf16_t* rowp = base + (size_t)(row0 + ai * HALF + m * 16) * ldc + col0;
#pragma unroll
            for (int bj = 0; bj < 2; ++bj) { const f32x4 v0 = acc[ai][bj][m][0] * sc, v1 = acc[ai][bj][m][1] * sc;
                u32x4 w; w.x = cvt_pk_bf16(v0[0], v0[1]); w.y = cvt_pk_bf16(v0[2], v0[3]); w.z = cvt_pk_bf16(v1[0], v1[1]); w.w = cvt_pk_bf16(v1[2], v1[3]);
                *(u32x4*)(rowp + bj * HALF) = w; } }
}
struct EpiBf16 {
    static constexpr bool PERM = true, AFTER_DRAIN = false;
    bf16_t* O; int ldc; float scale;
    __device__ __forceinline__ void operator()(const f32x4 (&acc)[2][2][4][2], const Unit& u, int wr, int wc, int fr, int fq) const {
        store_bf16_tile(acc, O + (size_t)u.pm * BM * ldc + u.pn * BM, ldc, scale, wr, wc, fr, fq);
    }
};
struct EpiProj {
    static constexpr bool PERM = true, AFTER_DRAIN = false;
    bf16_t* O; float* gates;
    __device__ __forceinline__ void operator()(const f32x4 (&acc)[2][2][4][2], const Unit& u, int wr, int wc, int fr, int fq) const {
        store_bf16_tile(acc, O + (size_t)u.pm * BM * NPROJ + u.pn * BM, NPROJ, 1.0f, wr, wc, fr, fq);
        if (u.pn == 15 && wc == 0 && fq == 0) {
#pragma unroll
            for (int ai = 0; ai < 2; ++ai)
#pragma unroll
                for (int m = 0; m < 4; ++m) { float* g = gates + (size_t)(u.pm * BM + ai * HALF + wr * 64 + m * 16 + fr) * 8;
                    *(f32x4*)g = acc[ai][0][m][0]; *(f32x4*)(g + 4) = acc[ai][0][m][1]; }
        }
    }
};
struct EpiKv {
    static constexpr bool PERM = true, AFTER_DRAIN = false;
    bf16_t* Kb; bf16_t* Vt;
    __device__ __forceinline__ void operator()(const f32x4 (&acc)[2][2][4][2], const Unit& u, int wr, int wc, int fr, int fq) const {
        const int layer = u.e >> 1;
        if (u.e & 1) store_bf16_tile(acc, Vt + (size_t)layer * 1024 * 2048 + (size_t)u.pm * BM * 2048 + u.pn * BM, 2048, 1.0f, wr, wc, fr, fq);
        else store_bf16_tile(acc, Kb + (size_t)layer * 2048 * 1024 + (size_t)u.pm * BM * 1024 + u.pn * BM, 1024, 1.0f, wr, wc, fr, fq);
    }
};
struct EpiPv {
    static constexpr bool PERM = true, AFTER_DRAIN = false;
    bf16_t* O;
    __device__ __forceinline__ void operator()(const f32x4 (&acc)[2][2][4][2], const Unit& u, int wr, int wc, int fr, int fq) const {
        const int b = u.e >> 2, hd = u.e & 3;
        store_bf16_tile(acc, O + ((size_t)b * 2048 + (size_t)u.pm * 256) * 1024 + hd * 256, 1024, 1.0f, wr, wc, fr, fq);
    }
};
struct EpiSoftmax {
    static constexpr bool PERM = true, AFTER_DRAIN = true;
    bf16_t* P;
    __device__ __forceinline__ void fused(f32x4 (&acc)[2][2][4][2], const Unit& u, int wr, int wc, int fr, int fq, LAS unsigned char* lds, int wid, int lane) const {
        LAS f32x2* tab = (LAS f32x2*)lds;
#pragma unroll
        for (int ai = 0; ai < 2; ++ai)
#pragma unroll
            for (int m = 0; m < 4; ++m) {
                float mx = -3.0e38f;
#pragma unroll
                for (int bj = 0; bj < 2; ++bj)
#pragma unroll
                    for (int n = 0; n < 2; ++n) { const f32x4 x = acc[ai][bj][m][n]; mx = fmaxf(mx, fmaxf(fmaxf(x[0], x[1]), fmaxf(x[2], x[3]))); }
                mx = fmaxf(mx, __shfl_xor(mx, 16)); mx = fmaxf(mx, __shfl_xor(mx, 32));
                float s = 0.f;
#pragma unroll
                for (int bj = 0; bj < 2; ++bj)
#pragma unroll
                    for (int n = 0; n < 2; ++n) { const f32x4 x = acc[ai][bj][m][n]; s += (__expf(x[0] - mx) + __expf(x[1] - mx)) + (__expf(x[2] - mx) + __expf(x[3] - mx)); }
                s += __shfl_xor(s, 16); s += __shfl_xor(s, 32);
                if (fq == 0) tab[(ai * HALF + wr * 64 + m * 16 + fr) * 4 + wc] = (f32x2){mx, s};
            }
        LDS_WAIT(); __builtin_amdgcn_s_barrier(); asm volatile("" ::: "memory");
        bf16_t* base = P + ((size_t)u.e * 2048 + (size_t)u.pm * 256) * 256;
#pragma unroll
        for (int ai = 0; ai < 2; ++ai)
#pragma unroll
            for (int m = 0; m < 4; ++m) { const int r = ai * HALF + wr * 64 + m * 16 + fr;
                const f32x2 p0 = tab[r * 4 + 0], p1 = tab[r * 4 + 1], p2 = tab[r * 4 + 2], p3 = tab[r * 4 + 3];
                const float M = fmaxf(fmaxf(p0.x, p1.x), fmaxf(p2.x, p3.x));
                const float ssum = p0.y * __expf(p0.x - M) + p1.y * __expf(p1.x - M) + p2.y * __expf(p2.x - M) + p3.y * __expf(p3.x - M);
                const float inv = 1.0f / ssum;
                bf16_t* rowp = base + (size_t)r * 256 + wc * 32 + 8 * fq;
#pragma unroll
                for (int bj = 0; bj < 2; ++bj) { const f32x4 x0 = acc[ai][bj][m][0], x1 = acc[ai][bj][m][1];
                    u32x4 w; w.x = cvt_pk_bf16(__expf(x0[0] - M) * inv, __expf(x0[1] - M) * inv); w.y = cvt_pk_bf16(__expf(x0[2] - M) * inv, __expf(x0[3] - M) * inv);
                    w.z = cvt_pk_bf16(__expf(x1[0] - M) * inv, __expf(x1[1] - M) * inv); w.w = cvt_pk_bf16(__expf(x1[2] - M) * inv, __expf(x1[3] - M) * inv);
                    *(u32x4*)(rowp + bj * HALF) = w; } }
        LDS_WAIT(); __builtin_amdgcn_s_barrier(); asm volatile("" ::: "memory");
    }
};
struct EpiSwiglu {
    static constexpr bool PERM = true, AFTER_DRAIN = false;
    bf16_t* G; const float* b1;
    __device__ __forceinline__ void operator()(const f32x4 (&acc)[2][2][4][2], const Unit& u, int wr, int wc, int fr, int fq) const {
        const int cin = wc * 32 + 8 * fq;
        const float* bg = b1 + (size_t)u.e * 2048 + u.pn * 128 + cin; const float* bu = bg + 1024;
        const f32x4 g0 = *(const f32x4*)bg, g1 = *(const f32x4*)(bg + 4), u0 = *(const f32x4*)bu, u1 = *(const f32x4*)(bu + 4);
#pragma unroll
        for (int ai = 0; ai < 2; ++ai)
#pragma unroll
            for (int m = 0; m < 4; ++m) {
                bf16_t* rowp = G + (size_t)(u.pm * BM + ai * HALF + wr * 64 + m * 16 + fr) * 1024 + u.pn * 128 + cin;
                float o[8];
#pragma unroll
                for (int n = 0; n < 2; ++n) { const f32x4 ga = acc[ai][0][m][n] + (n ? g1 : g0), up = acc[ai][1][m][n] + (n ? u1 : u0);
#pragma unroll
                    for (int j = 0; j < 4; ++j) { const float gt = fminf(ga[j], 7.0f), uu = fminf(fmaxf(up[j], -7.0f), 7.0f);
                        const float glu = gt / (1.0f + __expf(-1.702f * gt)); o[n * 4 + j] = (uu + 1.0f) * glu; } }
                u32x4 w; w.x = cvt_pk_bf16(o[0], o[1]); w.y = cvt_pk_bf16(o[2], o[3]); w.z = cvt_pk_bf16(o[4], o[5]); w.w = cvt_pk_bf16(o[6], o[7]);
                *(u32x4*)rowp = w; }
    }
};
struct EpiMoeY {
    static constexpr bool PERM = true, AFTER_DRAIN = false;
    bf16_t* Y; const float* b2;
    __device__ __forceinline__ void operator()(const f32x4 (&acc)[2][2][4][2], const Unit& u, int wr, int wc, int fr, int fq) const {
        const int col0 = u.pn * BM + wc * 32 + 8 * fq;
        f32x4 bv[2][2];
#pragma unroll
        for (int bj = 0; bj < 2; ++bj)
#pragma unroll
            for (int n = 0; n < 2; ++n) bv[bj][n] = *(const f32x4*)(b2 + (size_t)u.e * 1024 + col0 + bj * HALF + 4 * n);
#pragma unroll
        for (int ai = 0; ai < 2; ++ai)
#pragma unroll
            for (int m = 0; m < 4; ++m) { bf16_t* rowp = Y + (size_t)(u.pm * BM + ai * HALF + wr * 64 + m * 16 + fr) * 1024 + col0;
#pragma unroll
                for (int bj = 0; bj < 2; ++bj) { const f32x4 v0 = acc[ai][bj][m][0] + bv[bj][0], v1 = acc[ai][bj][m][1] + bv[bj][1];
                    u32x4 w; w.x = cvt_pk_bf16(v0[0], v0[1]); w.y = cvt_pk_bf16(v0[2], v0[3]); w.z = cvt_pk_bf16(v1[0], v1[1]); w.w = cvt_pk_bf16(v1[2], v1[3]);
                    *(u32x4*)(rowp + bj * HALF) = w; } }
    }
};
}

struct Args { const float* in[37]; float* out; unsigned char* ws; int ph_lo, ph_hi; };
constexpr int TAB_OFF = MISC_OFF + 8192;
struct InTab {
    LAS const volatile unsigned* t;
    __device__ __forceinline__ const void* get(int k) const { unsigned lo = t[2 * k], hi = t[2 * k + 1]; lo = __builtin_amdgcn_readfirstlane(lo); hi = __builtin_amdgcn_readfirstlane(hi); return (const void*)(((unsigned long long)hi << 32) | lo); }
    __device__ __forceinline__ const float* operator[](int k) const { return (const float*)get(k); }
};
struct Ctx {
    LAS unsigned char* lds; int tid, lane, wave, blk, G, gw, ngw;
    InTab in; float* out; unsigned char* ws;
};
template <class Tp> __device__ __forceinline__ Tp* wsp(const Ctx& F, size_t off) { return (Tp*)(F.ws + off); }

__device__ __forceinline__ void ln_row_store(f32x4 (&v)[4], const float* g, const float* b, float* hrow, bf16_t* hbrow, int lane) {
    float s = 0.f;
#pragma unroll
    for (int j = 0; j < 4; ++j) s += (v[j][0] + v[j][1]) + (v[j][2] + v[j][3]);
    const float mean = wave_sum(s) * (1.0f / 1024.0f); float s2 = 0.f;
#pragma unroll
    for (int j = 0; j < 4; ++j) { v[j] = v[j] - mean; s2 += (v[j][0] * v[j][0] + v[j][1] * v[j][1]) + (v[j][2] * v[j][2] + v[j][3] * v[j][3]); }
    const float rstd = 1.0f / sqrtf(wave_sum(s2) * (1.0f / 1024.0f) + 1e-5f);
#pragma unroll
    for (int j = 0; j < 4; ++j) {
        const f32x4 gg = *(const f32x4*)(g + 256 * j + 4 * lane), bb = *(const f32x4*)(b + 256 * j + 4 * lane);
        const f32x4 o = v[j] * rstd * gg + bb;
        *(f32x4*)(hrow + 256 * j + 4 * lane) = o;
        if (hbrow) { u32x2 w; w.x = pk2(o[0], o[1]); w.y = pk2(o[2], o[3]); *(u32x2*)(hbrow + 256 * j + 4 * lane) = w; }
    }
}

__device__ __forceinline__ int map_row(int kind, int n) {
    if (kind == 1) return n < 2048 ? n : (n < 2056 ? 3840 + (n - 2048) : n - 8);
    if (kind == 2) { const int j = n & 1023; return (j >> 7) * 256 + ((n >> 10) << 7) + (j & 127); }
    return n;
}
__device__ __forceinline__ void transpose_item(const float* W, int N, bf16_t* WT, int kind, LAS float* scr, int item, int lane) {
    const int nblk = (N + 31) >> 5, kb = item / nblk, nb = item % nblk, k0 = 64 * kb, n0 = 32 * nb;
    const int nn = n0 + (lane & 31); const bool ok = nn < N;
#pragma unroll 8
    for (int i = 0; i < 32; ++i) { const int kk = 2 * i + (lane >> 5); scr[kk * 33 + (lane & 31)] = ok ? W[(size_t)(k0 + kk) * N + nn] : 0.f; }
    LDS_WAIT(); asm volatile("" ::: "memory");
    const int c = lane & 7;
#pragma unroll
    for (int j = 0; j < 4; ++j) { const int n = (lane >> 3) + 8 * j; const LAS float* s = scr + (8 * c) * 33 + n;
        if (n0 + n < N) { u32x4 o; o.x = pk2(s[0 * 33], s[1 * 33]); o.y = pk2(s[2 * 33], s[3 * 33]); o.z = pk2(s[4 * 33], s[5 * 33]); o.w = pk2(s[6 * 33], s[7 * 33]);
            *(u32x4*)(WT + (size_t)map_row(kind, n0 + n) * 1024 + k0 + 8 * c) = o; } }
    LDS_WAIT(); asm volatile("" ::: "memory");
}
__device__ __forceinline__ void phase_prologue(const Ctx& F) {
    LAS float* scr = (LAS float*)(F.lds + F.wave * 16384);
    constexpr int I_IN = 16 * 121, I_SQ = 16 * 32, I_KV = 16 * 64, I_W1 = 16 * 64, I_W2 = 16 * 32;
    constexpr int PER_LAYER = I_IN + 3 * I_SQ + I_KV + 32 * I_W1 + 32 * I_W2;
    const float* p_win = F.in[4]; const float* p_wout = F.in[21]; const float* p_wq = F.in[24]; const float* p_wkv = F.in[25]; const float* p_wo = F.in[26]; const float* p_w1 = F.in[31]; const float* p_w2 = F.in[33];
    for (int it = F.gw; it < 2 * PER_LAYER; it += F.ngw) {
        const int l = it / PER_LAYER; int r = it % PER_LAYER;
        if (r < I_IN) { transpose_item(p_win + (size_t)l * 1024 * IN_COLS, IN_COLS, wsp<bf16_t>(F, WS_WIN) + (size_t)l * 4096 * 1024, 1, scr, r, F.lane); continue; } r -= I_IN;
        if (r < I_SQ) { transpose_item(p_wout + (size_t)l * 1024 * 1024, 1024, wsp<bf16_t>(F, WS_WOUT) + (size_t)l * 1024 * 1024, 0, scr, r, F.lane); continue; } r -= I_SQ;
        if (r < I_SQ) { transpose_item(p_wq + (size_t)l * 1024 * 1024, 1024, wsp<bf16_t>(F, WS_WQ) + (size_t)l * 1024 * 1024, 0, scr, r, F.lane); continue; } r -= I_SQ;
        if (r < I_KV) { transpose_item(p_wkv + (size_t)l * 1024 * 2048, 2048, wsp<bf16_t>(F, WS_WKV) + (size_t)l * 2048 * 1024, 0, scr, r, F.lane); continue; } r -= I_KV;
        if (r < I_SQ) { transpose_item(p_wo + (size_t)l * 1024 * 1024, 1024, wsp<bf16_t>(F, WS_WO) + (size_t)l * 1024 * 1024, 0, scr, r, F.lane); continue; } r -= I_SQ;
        if (r < 32 * I_W1) { const int e = r / I_W1; transpose_item(p_w1 + ((size_t)l * 32 + e) * 1024 * 2048, 2048, wsp<bf16_t>(F, WS_W1) + ((size_t)l * 32 + e) * 2048 * 1024, 2, scr, r % I_W1, F.lane); continue; } r -= 32 * I_W1;
        { const int e = r / I_W2; transpose_item(p_w2 + ((size_t)l * 32 + e) * 1024 * 1024, 1024, wsp<bf16_t>(F, WS_W2) + ((size_t)l * 32 + e) * 1024 * 1024, 0, scr, r % I_W2, F.lane); }
    }
    const int gt = F.blk * NTHREADS + F.tid, ngt = F.G * NTHREADS;
    for (int i = gt; i < 2 * 248 * 128; i += ngt) { const int l = i / (248 * 128), r = i % (248 * 128); *(u32x4*)(wsp<bf16_t>(F, WS_WIN) + ((size_t)l * 4096 + 3848) * 1024 + (size_t)r * 8) = (u32x4){0u, 0u, 0u, 0u}; }
    const float* pw2 = F.in[12]; const float* pa2 = F.in[14]; const float* pg2 = F.in[15];
    for (int i = gt; i < 2 * 1536 * 256; i += ngt) {
        const int l = i / (1536 * 256), r = i % (1536 * 256), n = r >> 8, k = r & 255; float v = 0.f;
        if (n < 512) { if (k < 64) v = pw2[((size_t)l * 64 + k) * 512 + n]; }
        else if (n < 1024) { if (k >= 64 && k < 128) v = pa2[((size_t)l * 64 + (k - 64)) * 512 + (n - 512)]; }
        else { if (k >= 128) v = pg2[((size_t)l * 128 + (k - 128)) * 512 + (n - 1024)]; }
        wsp<bf16_t>(F, WS_WLR)[i] = (bf16_t)f2bf(v);
    }
    const f32x4* pmem = (const f32x4*)F.in[1];
    for (int i = gt; i < 2048 * 1024 / 4; i += ngt) { const f32x4 v = pmem[i]; u32x2 w; w.x = pk2(v[0], v[1]); w.y = pk2(v[2], v[3]); ((u32x2*)wsp<bf16_t>(F, WS_MEMB))[i] = w; }
    const float* px = F.in[0]; const float* pg0 = F.in[2]; const float* pb0 = F.in[3];
    for (int m = F.gw; m < T_TOK; m += F.ngw) {
        f32x4 v[4]; const float* xr = px + (size_t)m * DM;
#pragma unroll
        for (int j = 0; j < 4; ++j) v[j] = *(const f32x4*)(xr + 256 * j + 4 * F.lane);
        ln_row_store(v, pg0, pb0, wsp<float>(F, WS_H) + (size_t)m * DM, wsp<bf16_t>(F, WS_HB) + (size_t)m * DM, F.lane);
    }
}

__device__ __forceinline__ void phase_ln_add(const Ctx& F, const float* g, const float* b) {
    for (int m = F.gw; m < T_TOK; m += F.ngw) {
        f32x4 v[4]; const float* hr = wsp<float>(F, WS_H) + (size_t)m * DM; const float* cr = wsp<float>(F, WS_CF) + (size_t)m * DM;
#pragma unroll
        for (int j = 0; j < 4; ++j) v[j] = *(const f32x4*)(hr + 256 * j + 4 * F.lane) * DN_ALPHA + *(const f32x4*)(cr + 256 * j + 4 * F.lane);
        ln_row_store(v, g, b, wsp<float>(F, WS_H) + (size_t)m * DM, wsp<bf16_t>(F, WS_HB) + (size_t)m * DM, F.lane);
    }
}
__device__ __forceinline__ void phase_ln_moe(const Ctx& F, const float* g, const float* b, bool last) {
    const int* slot = wsp<int>(F, SM_SLOT); const float* tg = wsp<float>(F, SM_TOPG); const bf16_t* Y = wsp<bf16_t>(F, WS_YB);
    for (int m = F.gw; m < T_TOK; m += F.ngw) {
        f32x4 v[4]; const float* hr = wsp<float>(F, WS_H) + (size_t)m * DM;
#pragma unroll
        for (int j = 0; j < 4; ++j) v[j] = *(const f32x4*)(hr + 256 * j + 4 * F.lane) * DN_ALPHA;
#pragma unroll
        for (int k = 0; k < 4; ++k) { const int sl = slot[m * 4 + k]; const float gk = tg[m * 4 + k]; const bf16_t* yr = Y + (size_t)sl * DM;
#pragma unroll
            for (int j = 0; j < 4; ++j) { const u32x2 w = *(const u32x2*)(yr + 256 * j + 4 * F.lane);
                v[j][0] += gk * bflo(w.x); v[j][1] += gk * bfhi(w.x); v[j][2] += gk * bflo(w.y); v[j][3] += gk * bfhi(w.y); } }
        float* dst = last ? F.out + (size_t)m * DM : wsp<float>(F, WS_H) + (size_t)m * DM;
        ln_row_store(v, g, b, dst, last ? (bf16_t*)nullptr : wsp<bf16_t>(F, WS_HB) + (size_t)m * DM, F.lane);
    }
}

__device__ __forceinline__ void phase_xlr(const Ctx& F, int l) {
    const bf16_t* proj = wsp<bf16_t>(F, WS_PROJ); bf16_t* xlr = wsp<bf16_t>(F, WS_XLR); const float* mu = F.in[10] + (size_t)l * 1792 + 1536;
    const int gt = F.blk * NTHREADS + F.tid, ngt = F.G * NTHREADS;
    for (int i = gt; i < T_TOK * 32; i += ngt) {
        const int t = i >> 5, c8 = (i & 31) * 8;
        const u32x4 p = *(const u32x4*)(proj + (size_t)t * NPROJ + RC0 + 1536 + c8);
        u32x4 q = (u32x4){0u, 0u, 0u, 0u}; if ((t & (SEQ - 1)) != 0) q = *(const u32x4*)(proj + (size_t)(t - 1) * NPROJ + RC0 + 1536 + c8);
        float o[8];
#pragma unroll
        for (int j = 0; j < 4; ++j) { const float a0 = bflo(p[j]), a1 = bfhi(p[j]), b0 = bflo(q[j]), b1 = bfhi(q[j]);
            o[2 * j] = a0 + (b0 - a0) * mu[c8 + 2 * j]; o[2 * j + 1] = a1 + (b1 - a1) * mu[c8 + 2 * j + 1]; }
#pragma unroll
        for (int j = 0; j < 8; ++j) { if (c8 < 64) o[j] = tanhf(o[j]); else if (c8 >= 128) o[j] = sigmoidf_(o[j]); }
        u32x4 w; w.x = pk2(o[0], o[1]); w.y = pk2(o[2], o[3]); w.z = pk2(o[4], o[5]); w.w = pk2(o[6], o[7]);
        *(u32x4*)(xlr + (size_t)t * 256 + c8) = w;
    }
}

__device__ __forceinline__ void phase_rwkv_prep(const Ctx& F, int l) {
    const bf16_t* proj = wsp<bf16_t>(F, WS_PROJ); const float* lr = wsp<float>(F, WS_LR); float* rec = wsp<float>(F, WS_REC); float* gv = wsp<float>(F, WS_GV); float* bon = wsp<float>(F, SM_BON);
    const float* mu = F.in[10] + (size_t)l * 1792; const float* w0 = F.in[11] + l * 512; const float* a0 = F.in[13] + l * 512;
    const float* pkk = F.in[16] + l * 512; const float* pka = F.in[17] + l * 512; const float* prk = F.in[18] + l * 512;
    for (int item = F.gw; item < T_TOK * 8; item += F.ngw) {
        const int t = item >> 3, h = item & 7, c = h * 64 + F.lane, s = t & (SEQ - 1), bh = (t >> 11) * 8 + h;
        const bf16_t* pr = proj + (size_t)t * NPROJ + RC0; const bool hasp = s != 0;
        float xr = bf2f(pr[c]), xk = bf2f(pr[512 + c]), xv = bf2f(pr[1024 + c]);
        const float yr = hasp ? bf2f(pr[c - NPROJ]) : 0.f, yk = hasp ? bf2f(pr[512 + c - NPROJ]) : 0.f, yv = hasp ? bf2f(pr[1024 + c - NPROJ]) : 0.f;
        xr = xr + (yr - xr) * mu[c]; xk = xk + (yk - xk) * mu[512 + c]; xv = xv + (yv - xv) * mu[1024 + c];
        const float* lrow = lr + (size_t)t * 1536;
        const float wpre = w0[c] + lrow[c];
        const float wlog = -softplusf_(-wpre) - 0.5f;
        const float d = __expf(-__expf(wlog));
        const float a = sigmoidf_(a0[c] + lrow[512 + c]);
        const float g = lrow[1024 + c];
        float kk = xk * pkk[c];
        const float nrm = sqrtf(wave_sum(kk * kk)); kk = kk / fmaxf(nrm, 1e-12f);
        const float kp = xk * (1.0f + (a - 1.0f) * pka[c]);
        const float beta = kk * a;
        const float c1 = wave_sum(beta * xr), c2 = wave_sum(kp * xr), bs = wave_sum(xr * kp * prk[c]);
        float* rp = rec + ((size_t)bh * SEQ + s) * RECF;
        rp[F.lane] = -kk; rp[64 + F.lane] = beta; rp[128 + F.lane] = d; rp[192 + F.lane] = kp; rp[256 + F.lane] = d * xr; rp[320 + F.lane] = xv;
        if (F.lane < 4) rp[384 + F.lane] = F.lane == 0 ? c1 : (F.lane == 1 ? c2 : 0.f);
        gv[(size_t)t * 512 + c] = g;
        if (F.lane == 0) bon[t * 8 + h] = bs;
    }
}

template <int CTRL> __device__ __forceinline__ float dpp_f(float x) { return __builtin_bit_cast(float, __builtin_amdgcn_update_dpp(0, __builtin_bit_cast(int, x), CTRL, 0xF, 0xF, true)); }
__device__ __forceinline__ float allreduce16(float x) { x += dpp_f<0x128>(x); x += dpp_f<0x124>(x); x += dpp_f<0x122>(x); x += dpp_f<0x121>(x); return x; }
__device__ __forceinline__ void phase_rwkv_scan(const Ctx& F) {
    if (F.blk >= 128) return;
    constexpr int TB = 16, CHF = TB * RECF, CH4 = CHF / 4;
    LAS float* buf = (LAS float*)F.lds;
    LAS float* ybuf = (LAS float*)(F.lds + 2 * CHF * 4);
    const int bh = F.blk >> 1, half = F.blk & 1, b = bh >> 3, h = bh & 7;
    const int r = F.lane >> 4, g = F.lane & 15, rowl = F.wave * 4 + r;
    const float* recbase = wsp<float>(F, WS_REC) + (size_t)bh * SEQ * RECF;
    float* yout = wsp<float>(F, WS_YR);
    for (int i = F.tid; i < CH4; i += NTHREADS) ((LAS f32x4*)buf)[i] = ((const f32x4*)recbase)[i];
    __syncthreads();
    f32x4 S = (f32x4){0.f, 0.f, 0.f, 0.f};
    for (int ci = 0; ci < SEQ / TB; ++ci) {
        f32x4 pre[4];
        if (ci + 1 < SEQ / TB) {
#pragma unroll
            for (int q = 0; q < 4; ++q) { const int idx = F.tid + q * NTHREADS; if (idx < CH4) pre[q] = ((const f32x4*)(recbase + (size_t)(ci + 1) * CHF))[idx]; }
        }
        const LAS float* cur = buf + (ci & 1) * CHF; LAS float* yb = ybuf + (ci & 1) * (TB * 32);
#pragma unroll 4
        for (int st = 0; st < TB; ++st) {
            const LAS float* rp = cur + st * RECF;
            const f32x4 nk = *(const LAS f32x4*)(rp + 4 * g), be = *(const LAS f32x4*)(rp + 64 + 4 * g), dd = *(const LAS f32x4*)(rp + 128 + 4 * g);
            const f32x4 kp = *(const LAS f32x4*)(rp + 192 + 4 * g), dr = *(const LAS f32x4*)(rp + 256 + 4 * g);
            const float vv = rp[320 + half * 32 + rowl], c1 = rp[384], c2 = rp[385];
            float sa = (S[0] * nk[0] + S[1] * nk[1]) + (S[2] * nk[2] + S[3] * nk[3]);
            float p = (S[0] * dr[0] + S[1] * dr[1]) + (S[2] * dr[2] + S[3] * dr[3]);
            sa = allreduce16(sa); p = allreduce16(p);
            S = S * dd + (be * sa + kp * vv);
            const float y = p + sa * c1 + vv * c2;
            if (g == 0) yb[st * 32 + rowl] = y;
        }
        if (ci + 1 < SEQ / TB) {
#pragma unroll
            for (int q = 0; q < 4; ++q) { const int idx = F.tid + q * NTHREADS; if (idx < CH4) ((LAS f32x4*)(buf + ((ci + 1) & 1) * CHF))[idx] = pre[q]; }
        }
        __syncthreads();
        { const int st = F.tid >> 5, rr = F.tid & 31; yout[((size_t)b * SEQ + ci * TB + st) * 512 + h * 64 + half * 32 + rr] = yb[F.tid]; }
    }
}
__device__ __forceinline__ void phase_rwkv_post(const Ctx& F, int l) {
    const float* yr = wsp<float>(F, WS_YR); const float* rec = wsp<float>(F, WS_REC); const float* gv = wsp<float>(F, WS_GV); const float* bon = wsp<float>(F, SM_BON);
    const float* gng = F.in[19] + l * 512; const float* gnb = F.in[20] + l * 512; bf16_t* mixed = wsp<bf16_t>(F, WS_MIXED);
    for (int item = F.gw; item < T_TOK * 8; item += F.ngw) {
        const int t = item >> 3, h = item & 7, c = h * 64 + F.lane, s = t & (SEQ - 1), bh = (t >> 11) * 8 + h;
        const float y = yr[(size_t)t * 512 + c];
        const float mean = wave_sum(y) * (1.0f / 64.0f); const float dv = y - mean;
        const float var = wave_sum(dv * dv) * (1.0f / 64.0f);
        const float yn = dv * (1.0f / sqrtf(var + 64e-5f)) * gng[c] + gnb[c];
        const float v = rec[((size_t)bh * SEQ + s) * RECF + 320 + F.lane];
        const float o = (yn + bon[t * 8 + h] * v) * gv[(size_t)t * 512 + c];
        mixed[(size_t)t * DM + 512 + c] = (bf16_t)f2bf(o);
    }
}

__device__ __forceinline__ void conv8(const bf16_t* proj, int t, int sabs, int col, const float* cw, const float* cb, float (&o)[2][8]) {
    float x[5][8];
#pragma unroll
    for (int i = 0; i < 5; ++i) { const int sa = sabs - 3 + i; u32x4 w = (u32x4){0u, 0u, 0u, 0u}; if (sa >= 0) w = *(const u32x4*)(proj + (size_t)(t - 3 + i) * NPROJ + col);
#pragma unroll
        for (int j = 0; j < 4; ++j) { x[i][2 * j] = bflo(w[j]); x[i][2 * j + 1] = bfhi(w[j]); } }
#pragma unroll
    for (int e = 0; e < 8; ++e) { const float w0 = cw[0 * 1024 + col + e], w1 = cw[1 * 1024 + col + e], w2 = cw[2 * 1024 + col + e], w3 = cw[3 * 1024 + col + e], bb = cb[col + e];
#pragma unroll
        for (int rr = 0; rr < 2; ++rr) { const float a = x[rr][e] * w0 + x[rr + 1][e] * w1 + x[rr + 2][e] * w2 + x[rr + 3][e] * w3 + bb; o[rr][e] = a * sigmoidf_(a); } }
}
__device__ __forceinline__ void phase_mlstm_prep(const Ctx& F, int l) {
    const bf16_t* proj = wsp<bf16_t>(F, WS_PROJ); const float* gates = wsp<float>(F, SM_GATES);
    bf16_t* qc = wsp<bf16_t>(F, WS_QC); bf16_t* kc = wsp<bf16_t>(F, WS_KC);
    float* bcum = wsp<float>(F, SM_BCUM); float* iga = wsp<float>(F, SM_IGA); float* mloc = wsp<float>(F, SM_MLOC); float* blast = wsp<float>(F, SM_BLAST);
    float* cloc = wsp<float>(F, WS_CLOC); float* nloc = wsp<float>(F, SM_NLOC);
    const float* cw = F.in[5] + (size_t)l * 4 * 1024; const float* cb = F.in[6] + (size_t)l * 1024; const float* igb = F.in[7] + l * 4; const float* fgb = F.in[8] + l * 4;
    LAS bf16_t* KT = (LAS bf16_t*)F.lds;
    LAS bf16_t* VT = (LAS bf16_t*)(F.lds + 18432);
    LAS float* wsrc = (LAS float*)(F.lds + 36864);
    for (int u = F.blk; u < 1024; u += F.G) {
        const int bh = u >> 5, c = u & 31, b = bh >> 2, h = bh & 3, t0 = b * SEQ + c * 64;
        if (F.wave == 0) {
            const int t = t0 + F.lane;
            const float ig = gates[(size_t)t * 8 + h] + igb[h]; const float f = gates[(size_t)t * 8 + 4 + h] + fgb[h];
            float x = -softplusf_(-f);
#pragma unroll
            for (int o = 1; o < 64; o <<= 1) { const float y = __shfl_up(x, o); if (F.lane >= o) x += y; }
            const float bl = __shfl(x, 63); const float src = bl - x + ig; const float ml = wave_max(src);
            wsrc[F.lane] = __expf(src - ml); bcum[(size_t)t * 4 + h] = x; iga[(size_t)t * 4 + h] = ig;
            if (F.lane == 0) { mloc[u] = ml; blast[u] = bl; }
        }
        __syncthreads();
        {
            const int jj = (F.tid & 15) * 8, s0 = (F.tid >> 4) * 2, t = t0 + s0, sabs = c * 64 + s0;
            float o[2][8];
            conv8(proj, t, sabs, h * 128 + jj, cw, cb, o);
#pragma unroll
            for (int rr = 0; rr < 2; ++rr) { u32x4 w; w.x = pk2(o[rr][0], o[rr][1]); w.y = pk2(o[rr][2], o[rr][3]); w.z = pk2(o[rr][4], o[rr][5]); w.w = pk2(o[rr][6], o[rr][7]);
                *(u32x4*)(qc + (size_t)(t + rr) * 512 + h * 128 + jj) = w; }
            conv8(proj, t, sabs, 512 + h * 128 + jj, cw, cb, o);
#pragma unroll
            for (int rr = 0; rr < 2; ++rr) { unsigned kb[8];
#pragma unroll
                for (int e = 0; e < 8; ++e) { kb[e] = f2bf(o[rr][e] * 0.08838834764831845f); KT[(jj + e) * 72 + s0 + rr] = (bf16_t)kb[e]; }
                u32x4 w; w.x = kb[0] | (kb[1] << 16); w.y = kb[2] | (kb[3] << 16); w.z = kb[4] | (kb[5] << 16); w.w = kb[6] | (kb[7] << 16);
                *(u32x4*)(kc + (size_t)(t + rr) * 512 + h * 128 + jj) = w; }
#pragma unroll
            for (int rr = 0; rr < 2; ++rr) { const u32x4 w = *(const u32x4*)(proj + (size_t)(t + rr) * NPROJ + 1024 + h * 128 + jj); const float ws = wsrc[s0 + rr];
#pragma unroll
                for (int j = 0; j < 4; ++j) { VT[(jj + 2 * j) * 72 + s0 + rr] = (bf16_t)f2bf(bflo(w[j]) * ws); VT[(jj + 2 * j + 1) * 72 + s0 + rr] = (bf16_t)f2bf(bfhi(w[j]) * ws); } }
        }
        __syncthreads();
        {
            const int fr = F.lane & 15, fq = F.lane >> 4;
            bf16x8 a[2];
#pragma unroll
            for (int ks = 0; ks < 2; ++ks) a[ks] = *(const LAS bf16x8*)(VT + (16 * F.wave + fr) * 72 + 32 * ks + 8 * fq);
            float* cbase = cloc + (size_t)u * 16384;
#pragma unroll
            for (int nt = 0; nt < 8; ++nt) {
                f32x4 acc = (f32x4){0.f, 0.f, 0.f, 0.f};
#pragma unroll
                for (int ks = 0; ks < 2; ++ks) { const bf16x8 bb = *(const LAS bf16x8*)(KT + (16 * nt + fr) * 72 + 32 * ks + 8 * fq); acc = __builtin_amdgcn_mfma_f32_16x16x32_bf16(a[ks], bb, acc, 0, 0, 0); }
#pragma unroll
                for (int rg = 0; rg < 4; ++rg) cbase[(16 * F.wave + 4 * fq + rg) * 128 + 16 * nt + fr] = acc[rg];
            }
            if (F.tid < 128) { float s = 0.f;
#pragma unroll 8
                for (int ss = 0; ss < 64; ++ss) s += wsrc[ss] * bf2f(KT[F.tid * 72 + ss]);
                nloc[(size_t)u * 128 + F.tid] = s; }
        }
        __syncthreads();
    }
}
__device__ __forceinline__ void phase_mlstm_scan(const Ctx& F) {
    const float* mloc = wsp<float>(F, SM_MLOC); const float* blast = wsp<float>(F, SM_BLAST); float* mprev = wsp<float>(F, SM_MPREV);
    const float* cloc = wsp<float>(F, WS_CLOC); const float* nloc = wsp<float>(F, SM_NLOC); bf16_t* cprev = wsp<bf16_t>(F, WS_CPREV);
    const int gt = F.blk * NTHREADS + F.tid, ngt = F.G * NTHREADS;
    for (int i = gt; i < 32 * 4096; i += ngt) {
        const int bh = i >> 12, q = i & 4095, e4 = q * 4;
        f32x4 C = (f32x4){0.f, 0.f, 0.f, 0.f}, nn = (f32x4){0.f, 0.f, 0.f, 0.f}; float m = 0.f;
        for (int c = 0; c < 32; ++c) {
            const int u = bh * 32 + c; bf16_t* cp = cprev + (size_t)u * 144 * 128;
            { u32x2 w; w.x = pk2(C[0], C[1]); w.y = pk2(C[2], C[3]); *(u32x2*)(cp + e4) = w; }
            if (q < 32) { u32x2 w; w.x = pk2(nn[0], nn[1]); w.y = pk2(nn[2], nn[3]); *(u32x2*)(cp + 128 * 128 + 4 * q) = w; }
            else if (q < 32 + 240) { *(u32x4*)(cp + 129 * 128 + (q - 32) * 8) = (u32x4){0u, 0u, 0u, 0u}; }
            if (q == 0) mprev[u] = m;
            const float bl = blast[u], ml = mloc[u];
            const float mn = fmaxf(bl + m, ml), a = __expf(bl + m - mn), cc = __expf(ml - mn);
            C = C * a + *(const f32x4*)(cloc + (size_t)u * 16384 + e4) * cc;
            if (q < 32) nn = nn * a + *(const f32x4*)(nloc + (size_t)u * 128 + 4 * q) * cc;
            m = mn;
        }
    }
}
__device__ __forceinline__ void phase_mlstm_out(const Ctx& F, int l, int first, int stride) {
    const bf16_t* proj = wsp<bf16_t>(F, WS_PROJ); const bf16_t* qc = wsp<bf16_t>(F, WS_QC); const bf16_t* kc = wsp<bf16_t>(F, WS_KC);
    const float* bcum = wsp<float>(F, SM_BCUM); const float* iga = wsp<float>(F, SM_IGA); const float* mprev = wsp<float>(F, SM_MPREV);
    const bf16_t* cprev = wsp<bf16_t>(F, WS_CPREV); bf16_t* mixed = wsp<bf16_t>(F, WS_MIXED); const float* ng = F.in[9] + l * 512;
    LAS bf16_t* VT = (LAS bf16_t*)F.lds;
    LAS bf16_t* PM = (LAS bf16_t*)(F.lds + 20736);
    LAS float* sc = (LAS float*)(F.lds + 20736 + 9216);
    const int fr = F.lane & 15, fq = F.lane >> 4;
    for (int u = first; u < 1024; u += stride) {
        const int bh = u >> 5, c = u & 31, b = bh >> 2, h = bh & 3, t0 = b * SEQ + c * 64;
        if (F.wave == 0) {
            const int t = t0 + F.lane; const float bb = bcum[(size_t)t * 4 + h], ig = iga[(size_t)t * 4 + h], mp = mprev[u];
            const float gqv = ig - bb; float pm = gqv;
#pragma unroll
            for (int o = 1; o < 64; o <<= 1) { const float y = __shfl_up(pm, o); if (F.lane >= o) pm = fmaxf(pm, y); }
            const float mt = bb + fmaxf(mp, pm);
            sc[F.lane] = bb - mt; sc[64 + F.lane] = gqv; sc[128 + F.lane] = __expf(bb + mp - mt); sc[192 + F.lane] = __expf(-mt);
        }
        {
            const int jj = (F.tid & 15) * 8, s0 = (F.tid >> 4) * 2;
#pragma unroll
            for (int rr = 0; rr < 2; ++rr) { const u32x4 w = *(const u32x4*)(proj + (size_t)(t0 + s0 + rr) * NPROJ + 1024 + h * 128 + jj);
#pragma unroll
                for (int j = 0; j < 4; ++j) { VT[(jj + 2 * j) * 72 + s0 + rr] = (bf16_t)(w[j] & 0xffffu); VT[(jj + 2 * j + 1) * 72 + s0 + rr] = (bf16_t)(w[j] >> 16); } }
            for (int i = F.tid; i < 16 * 64; i += NTHREADS) { const int rrow = i >> 6, cc = i & 63; VT[(128 + rrow) * 72 + cc] = rrow == 0 ? (bf16_t)0x3F80 : (bf16_t)0; }
        }
        __syncthreads();
        const int tt = F.wave & 3, hf = F.wave >> 2;
        bf16x8 qa[4];
#pragma unroll
        for (int ks = 0; ks < 4; ++ks) qa[ks] = *(const bf16x8*)(qc + (size_t)(t0 + 16 * tt + fr) * 512 + h * 128 + 32 * ks + 8 * fq);
        {
            const int trow = 16 * tt + fr; const float re = sc[trow];
#pragma unroll
            for (int si = 0; si < 2; ++si) { const int st = 2 * hf + si; f32x4 acc = (f32x4){0.f, 0.f, 0.f, 0.f};
#pragma unroll
                for (int ks = 0; ks < 4; ++ks) { const bf16x8 kb = *(const bf16x8*)(kc + (size_t)(t0 + 16 * st + fr) * 512 + h * 128 + 32 * ks + 8 * fq);
                    acc = __builtin_amdgcn_mfma_f32_16x16x32_bf16(kb, qa[ks], acc, 0, 0, 0); }
                float pv[4];
#pragma unroll
                for (int j = 0; j < 4; ++j) { const int s = 16 * st + 4 * fq + j; const float e = __expf(re + sc[64 + s]); pv[j] = (s <= trow) ? acc[j] * e : 0.f; }
                u32x2 w; w.x = pk2(pv[0], pv[1]); w.y = pk2(pv[2], pv[3]); *(LAS u32x2*)(PM + trow * 72 + 16 * st + 4 * fq) = w; }
        }
        __syncthreads();
        {
            const int trow = 16 * tt + fr, t = t0 + trow; const float wi = sc[128 + trow], enm = sc[192 + trow];
            bf16x8 pa[2];
#pragma unroll
            for (int ks = 0; ks < 2; ++ks) pa[ks] = *(const LAS bf16x8*)(PM + trow * 72 + 32 * ks + 8 * fq);
            const bf16_t* cp = cprev + (size_t)u * 144 * 128;
            f32x4 num[5];
#pragma unroll
            for (int ci = 0; ci < 5; ++ci) { const int ct = ci < 4 ? 4 * hf + ci : 8;
                f32x4 apv = (f32x4){0.f, 0.f, 0.f, 0.f}, ain = (f32x4){0.f, 0.f, 0.f, 0.f};
#pragma unroll
                for (int ks = 0; ks < 2; ++ks) { const bf16x8 vb = *(const LAS bf16x8*)(VT + (16 * ct + fr) * 72 + 32 * ks + 8 * fq); apv = __builtin_amdgcn_mfma_f32_16x16x32_bf16(vb, pa[ks], apv, 0, 0, 0); }
#pragma unroll
                for (int ks = 0; ks < 4; ++ks) { const bf16x8 cb = *(const bf16x8*)(cp + (size_t)(16 * ct + fr) * 128 + 32 * ks + 8 * fq); ain = __builtin_amdgcn_mfma_f32_16x16x32_bf16(cb, qa[ks], ain, 0, 0, 0); }
                num[ci] = apv + ain * wi; }
            const float den = __shfl(num[4][0], fr);
            const float dn = 1.0f / fmaxf(fabsf(den), enm);
            float s1 = 0.f;
#pragma unroll
            for (int ci = 0; ci < 4; ++ci) { num[ci] = num[ci] * dn; s1 += (num[ci][0] + num[ci][1]) + (num[ci][2] + num[ci][3]); }
            s1 += __shfl_xor(s1, 16); s1 += __shfl_xor(s1, 32);
            if (fq == 0) sc[256 + trow * 2 + hf] = s1;
            __syncthreads();
            const float mean = (sc[256 + trow * 2] + sc[256 + trow * 2 + 1]) * (1.0f / 128.0f);
            float s2 = 0.f;
#pragma unroll
            for (int ci = 0; ci < 4; ++ci) { num[ci] = num[ci] - mean; s2 += (num[ci][0] * num[ci][0] + num[ci][1] * num[ci][1]) + (num[ci][2] * num[ci][2] + num[ci][3] * num[ci][3]); }
            s2 += __shfl_xor(s2, 16); s2 += __shfl_xor(s2, 32);
            if (fq == 0) sc[384 + trow * 2 + hf] = s2;
            __syncthreads();
            const float rstd = 1.0f / sqrtf((sc[384 + trow * 2] + sc[384 + trow * 2 + 1]) * (1.0f / 128.0f) + 1e-5f);
#pragma unroll
            for (int ci = 0; ci < 4; ++ci) { const int col = h * 128 + 16 * (4 * hf + ci) + 4 * fq;
                const u32x2 mo = *(const u32x2*)(proj + (size_t)t * NPROJ + 1536 + col); const f32x4 gg = *(const f32x4*)(ng + col);
                const float o0 = num[ci][0] * rstd * gg[0] * sigmoidf_(bflo(mo.x)), o1 = num[ci][1] * rstd * gg[1] * sigmoidf_(bfhi(mo.x));
                const float o2 = num[ci][2] * rstd * gg[2] * sigmoidf_(bflo(mo.y)), o3 = num[ci][3] * rstd * gg[3] * sigmoidf_(bfhi(mo.y));
                u32x2 w; w.x = pk2(o0, o1); w.y = pk2(o2, o3); *(u32x2*)(mixed + (size_t)t * DM + col) = w; }
        }
        __syncthreads();
    }
}

__device__ __forceinline__ void phase_router(const Ctx& F, int l) {
    LAS float* W = (LAS float*)F.lds;
    LAS float* lg = (LAS float*)(F.lds + MISC_OFF);
    LAS unsigned* hist = (LAS unsigned*)(F.lds + MISC_OFF + 2048);
    const float* wr = F.in[29] + (size_t)l * 1024 * 32; const float* br = F.in[30] + l * 32;
    const float* H = wsp<float>(F, WS_H); int* topi = wsp<int>(F, SM_TOPI); float* topg = wsp<float>(F, SM_TOPG); unsigned* ctl = wsp<unsigned>(F, WS_CTL);
    for (int i = F.tid; i < 8192; i += NTHREADS) ((LAS f32x4*)W)[i] = ((const f32x4*)wr)[i];
    if (F.tid < 32) hist[F.tid] = 0u;
    __syncthreads();
    const int r = F.tid >> 5, e = F.tid & 31;
    for (int base = F.blk * 16; base < T_TOK; base += F.G * 16) {
        const int t = base + r; const float* hr = H + (size_t)t * DM;
        float a0 = br[e], a1 = 0.f, a2 = 0.f, a3 = 0.f;
#pragma unroll 4
        for (int d4 = 0; d4 < 256; ++d4) { const f32x4 hv = *(const f32x4*)(hr + 4 * d4); const LAS float* wp = W + (4 * d4) * 32 + e;
            a0 += hv[0] * wp[0]; a1 += hv[1] * wp[32]; a2 += hv[2] * wp[64]; a3 += hv[3] * wp[96]; }
        lg[r * 32 + e] = (a0 + a1) + (a2 + a3);
        __syncthreads();
        if (e == 0) {
            float v[4]; int id[4]; unsigned used = 0u;
#pragma unroll
            for (int k = 0; k < 4; ++k) { float best = -3.0e38f; int bi = 0;
                for (int j = 0; j < 32; ++j) { const float x = lg[r * 32 + j]; if (!((used >> j) & 1u) && x > best) { best = x; bi = j; } }
                used |= 1u << bi; v[k] = best; id[k] = bi; }
            const float e1 = __expf(v[1] - v[0]), e2 = __expf(v[2] - v[0]), e3 = __expf(v[3] - v[0]); const float inv = 1.0f / (1.0f + e1 + e2 + e3);
            topi[t * 4 + 0] = id[0]; topi[t * 4 + 1] = id[1]; topi[t * 4 + 2] = id[2]; topi[t * 4 + 3] = id[3];
            topg[t * 4 + 0] = inv; topg[t * 4 + 1] = e1 * inv; topg[t * 4 + 2] = e2 * inv; topg[t * 4 + 3] = e3 * inv;
#pragma unroll
            for (int k = 0; k < 4; ++k) atomicAdd((unsigned*)&hist[id[k]], 1u);
        }
        __syncthreads();
    }
    if (F.tid < 32 && hist[F.tid]) atomicAdd(&ctl[CW_CNT + l * 32 + F.tid], hist[F.tid]);
}
__device__ __forceinline__ void phase_slots(const Ctx& F, int l) {
    LAS unsigned* lc = (LAS unsigned*)F.lds; LAS unsigned* lbase = lc + 32; LAS unsigned* pst = lc + 64; LAS int* aslot = (LAS int*)(lc + 128); LAS int* atok = aslot + 256;
    unsigned* ctl = wsp<unsigned>(F, WS_CTL); const int* topi = wsp<int>(F, SM_TOPI); int* slotp = wsp<int>(F, SM_SLOT);
    const bf16_t* HB = wsp<bf16_t>(F, WS_HB); bf16_t* XG = wsp<bf16_t>(F, WS_XG);
    if (F.tid < 32) lc[F.tid] = 0u;
    if (F.tid == 0) { unsigned acc = 0u;
        for (int e = 0; e < 32; ++e) { pst[e] = acc; const unsigned c = ctl[CW_CNT + l * 32 + e]; acc += ((c + 255u) >> 8) << 8; }
        pst[32] = acc;
        if (F.blk == 0) for (int e = 0; e <= 32; ++e) ctl[CW_TILE + l * 40 + e] = pst[e] >> 8; }
    __syncthreads();
    for (int tb = F.blk; tb < T_TOK / 64; tb += F.G) {
        int myE = 0, myRank = 0, t = 0, k = 0;
        if (F.tid < 256) { t = tb * 64 + (F.tid >> 2); k = F.tid & 3; myE = topi[t * 4 + k]; myRank = (int)atomicAdd((unsigned*)&lc[myE], 1u); }
        __syncthreads();
        if (F.tid < 32) lbase[F.tid] = lc[F.tid] ? atomicAdd(&ctl[CW_CUR + l * 32 + F.tid], lc[F.tid]) : 0u;
        __syncthreads();
        if (F.tid < 256) { const int sl = (int)(pst[myE] + lbase[myE]) + myRank; slotp[t * 4 + k] = sl; aslot[F.tid] = sl; atok[F.tid] = t; }
        __syncthreads();
        if (F.tid < 32) lc[F.tid] = 0u;
        for (int a = 0; a < 32; ++a) { const int idx = F.wave * 32 + a; const int sl = aslot[idx], tk = atok[idx];
            const u32x4* src = (const u32x4*)(HB + (size_t)tk * DM); u32x4* dst = (u32x4*)(XG + (size_t)sl * DM);
            dst[F.lane] = src[F.lane]; dst[64 + F.lane] = src[64 + F.lane]; }
        __syncthreads();
    }
}

__device__ __forceinline__ const void* launder(const void* p) {
    unsigned long long x = (unsigned long long)p; unsigned lo = (unsigned)x, hi = (unsigned)(x >> 32);
    asm volatile("" : "+v"(lo), "+v"(hi));
    lo = __builtin_amdgcn_readfirstlane(lo); hi = __builtin_amdgcn_readfirstlane(hi);
    return (const void*)(((unsigned long long)hi << 32) | lo);
}
__device__ __forceinline__ void moe_build_units(const Ctx& F, int l, int npn) {
    LAS int* ul = (LAS int*)(F.lds + MISC_OFF + 4096);
    const unsigned* ts = wsp<unsigned>(F, WS_CTL) + CW_TILE + l * 40;
    if (F.tid < 16) {
        const int NT = (int)ts[32]; const long L = (long)F.tid * F.G + F.blk; int pm = -1, pn = 0, e = 0;
        if (L < (long)NT * npn) { pm = (int)(L / npn); pn = (int)(L % npn); for (int j = 1; j < 32; ++j) e += ((int)ts[j] <= pm) ? 1 : 0; }
        ul[3 * F.tid] = pm; ul[3 * F.tid + 1] = pn; ul[3 * F.tid + 2] = e;
    }
    __syncthreads();
}
constexpr int PH_PER_LAYER = 18, NPHASES = 2 + DEPTH * PH_PER_LAYER;
__global__ void __launch_bounds__(NTHREADS, 2) mk_fwd(Args args) {
    extern __shared__ __attribute__((aligned(16))) unsigned char lds_raw[];
    Ctx F; F.lds = (LAS unsigned char*)lds_raw; F.tid = threadIdx.x; F.lane = F.tid & 63; F.wave = __builtin_amdgcn_readfirstlane(F.tid >> 6);
    F.blk = blockIdx.x; F.G = gridDim.x; F.gw = F.blk * NWAVES + F.wave; F.ngw = F.G * NWAVES;
    {   LAS unsigned long long* tab = (LAS unsigned long long*)(F.lds + TAB_OFF);
        if (F.tid == 0) {
#define TB_(k) tab[k] = (unsigned long long)args.in[k];
            TB_(0) TB_(1) TB_(2) TB_(3) TB_(4) TB_(5) TB_(6) TB_(7) TB_(8) TB_(9) TB_(10) TB_(11) TB_(12) TB_(13) TB_(14) TB_(15) TB_(16) TB_(17) TB_(18)
            TB_(19) TB_(20) TB_(21) TB_(22) TB_(23) TB_(24) TB_(25) TB_(26) TB_(27) TB_(28) TB_(29) TB_(30) TB_(31) TB_(32) TB_(33) TB_(34) TB_(35) TB_(36)
#undef TB_
            tab[37] = (unsigned long long)args.out; tab[38] = (unsigned long long)args.ws; }
        __syncthreads();
        F.in.t = (LAS const volatile unsigned*)(F.lds + TAB_OFF); F.out = nullptr; F.ws = nullptr; }
    const int lo = args.ph_lo, hi = args.ph_hi;
#if ONE_LAUNCH
    cg::grid_group grid = cg::this_grid();
#define SEAM(k) do { if ((k) + 1 < hi) grid.sync(); } while (0)
#else
#define SEAM(k) do { } while (0)
#endif
#ifndef PHMASK
#define PHMASK 0xFFFFFu
#endif
#define IN(k) (lo <= (k) && (k) < hi)
#define ON(r) (((PHMASK) >> (r)) & 1u)
#define FRESH() do { int _t = threadIdx.x; int _b = blockIdx.x, _g = gridDim.x; unsigned _l = (unsigned)(uintptr_t)(LAS unsigned char*)lds_raw; asm volatile("" : "+v"(_t), "+s"(_b), "+s"(_g), "+s"(_l)); F.tid = _t; F.lane = _t & 63; F.wave = __builtin_amdgcn_readfirstlane(_t >> 6); F.blk = _b; F.G = _g; F.gw = _b * NWAVES + F.wave; F.ngw = _g * NWAVES; F.lds = (LAS unsigned char*)(uintptr_t)_l; lds = F.lds; F.in.t = (LAS const volatile unsigned*)(F.lds + TAB_OFF); F.out = (float*)F.in.get(37); F.ws = (unsigned char*)F.in.get(38); } while (0)
    LAS unsigned char* lds = F.lds;
    if (ON(18) && IN(0)) { FRESH(); phase_prologue(F); __syncthreads(); SEAM(0); }
    if (ON(19) && IN(1)) { FRESH();
        pg8::KvOrder S; S.memb = (const char*)wsp<bf16_t>(F, WS_MEMB); S.wkv = (const char*)wsp<bf16_t>(F, WS_WKV); S.lda = 1024; S.ldb = 1024; S.K = 1024; S.G = F.G; S.c = F.blk;
        pg8::EpiKv E{wsp<bf16_t>(F, WS_KBUF), wsp<bf16_t>(F, WS_VTB)};
        pg8::gemm_phase(lds, S, E); __syncthreads(); SEAM(1);
    }
    for (int l = 0; l < DEPTH; ++l) {
        const int pb = 2 + l * PH_PER_LAYER;
        if (ON(0) && IN(pb + 0)) { FRESH();
            pg8::DenseOrder S; S.init(wsp<bf16_t>(F, WS_HB), wsp<bf16_t>(F, WS_WIN) + (size_t)l * 4096 * 1024, T_TOK, NPROJ, 1024, 1024, 1024, F.G, F.blk);
            pg8::EpiProj E{wsp<bf16_t>(F, WS_PROJ), wsp<float>(F, SM_GATES)};
            pg8::gemm_phase(lds, S, E); __syncthreads(); SEAM(pb + 0);
        }
        if (ON(1) && IN(pb + 1)) { FRESH(); phase_xlr(F, l); phase_mlstm_prep(F, l); __syncthreads(); SEAM(pb + 1); }
        if (ON(2) && IN(pb + 2)) { FRESH();
            pg8::DenseOrder S; S.init(wsp<bf16_t>(F, WS_XLR), wsp<bf16_t>(F, WS_WLR) + (size_t)l * 1536 * 256, T_TOK, 1536, 256, 256, 256, F.G, F.blk);
            pg8::EpiF32 E{wsp<float>(F, WS_LR), 1536};
            pg8::gemm_phase(lds, S, E); __syncthreads();
            phase_mlstm_scan(F); SEAM(pb + 2);
        }
        if (ON(3) && IN(pb + 3)) { FRESH(); phase_rwkv_prep(F, l); SEAM(pb + 3); }
        if (ON(4) && IN(pb + 4)) { FRESH(); if (F.blk < 128) phase_rwkv_scan(F); else phase_mlstm_out(F, l, F.blk - 128, F.G - 128); __syncthreads(); SEAM(pb + 4); }
        if (ON(5) && IN(pb + 5)) { FRESH(); phase_rwkv_post(F, l); SEAM(pb + 5); }
        if (ON(6) && IN(pb + 6)) { FRESH();
            pg8::DenseOrder S; S.init(wsp<bf16_t>(F, WS_MIXED), wsp<bf16_t>(F, WS_WOUT) + (size_t)l * 1024 * 1024, T_TOK, 1024, 1024, 1024, 1024, F.G, F.blk);
            pg8::EpiF32 E{wsp<float>(F, WS_CF), 1024};
            pg8::gemm_phase(lds, S, E); __syncthreads(); SEAM(pb + 6);
        }
        if (ON(7) && IN(pb + 7)) { FRESH(); phase_ln_add(F, F.in[22] + l * 1024, F.in[23] + l * 1024); SEAM(pb + 7); }
        if (ON(8) && IN(pb + 8)) { FRESH();
            pg8::DenseOrder S; S.init(wsp<bf16_t>(F, WS_HB), wsp<bf16_t>(F, WS_WQ) + (size_t)l * 1024 * 1024, T_TOK, 1024, 1024, 1024, 1024, F.G, F.blk);
            pg8::EpiBf16 E{wsp<bf16_t>(F, WS_QB), 1024, 0.0625f};
            pg8::gemm_phase(lds, S, E); __syncthreads(); SEAM(pb + 8);
        }
        if (ON(9) && IN(pb + 9)) { FRESH();
            pg8::SOrder S; S.Q = (const char*)wsp<bf16_t>(F, WS_QB); S.Kb = (const char*)(wsp<bf16_t>(F, WS_KBUF) + (size_t)l * 2048 * 1024); S.lda = 1024; S.ldb = 1024; S.K = 256; S.G = F.G; S.c = F.blk;
            pg8::EpiSoftmax E{wsp<bf16_t>(F, WS_PB)};
            pg8::gemm_phase(lds, S, E); __syncthreads(); SEAM(pb + 9);
        }
        if (ON(10) && IN(pb + 10)) { FRESH();
            pg8::PvOrder S; S.P = (const char*)wsp<bf16_t>(F, WS_PB); S.Vt = (const char*)(wsp<bf16_t>(F, WS_VTB) + (size_t)l * 1024 * 2048); S.lda = 256; S.ldb = 2048; S.K = 256; S.G = F.G; S.c = F.blk;
            pg8::EpiPv E{wsp<bf16_t>(F, WS_OB)};
            pg8::gemm_phase(lds, S, E); __syncthreads(); SEAM(pb + 10);
        }
        if (ON(11) && IN(pb + 11)) { FRESH();
            pg8::DenseOrder S; S.init(wsp<bf16_t>(F, WS_OB), wsp<bf16_t>(F, WS_WO) + (size_t)l * 1024 * 1024, T_TOK, 1024, 1024, 1024, 1024, F.G, F.blk);
            pg8::EpiF32 E{wsp<float>(F, WS_CF), 1024};
            pg8::gemm_phase(lds, S, E); __syncthreads(); SEAM(pb + 11);
        }
        if (ON(12) && IN(pb + 12)) { FRESH(); phase_ln_add(F, F.in[27] + l * 1024, F.in[28] + l * 1024); SEAM(pb + 12); }
        if (ON(13) && IN(pb + 13)) { FRESH(); phase_router(F, l); __syncthreads(); SEAM(pb + 13); }
        if (ON(14) && IN(pb + 14)) { FRESH(); phase_slots(F, l); __syncthreads(); SEAM(pb + 14); }
        if (ON(15) && IN(pb + 15)) { FRESH();
            moe_build_units(F, l, 8);
            pg8::MoeOrder S; S.A = (const char*)wsp<bf16_t>(F, WS_XG); S.W = (const char*)(wsp<bf16_t>(F, WS_W1) + (size_t)l * 32 * 2048 * 1024); S.ul = (LAS const int*)(F.lds + MISC_OFF + 4096);
            S.wstride = (size_t)2048 * 1024 * 2; S.lda = 1024; S.ldb = 1024; S.K = 1024;
            pg8::EpiSwiglu E{wsp<bf16_t>(F, WS_GACT), F.in[32] + (size_t)l * 32 * 2048};
            pg8::gemm_phase(lds, S, E); __syncthreads(); SEAM(pb + 15);
        }
        if (ON(16) && IN(pb + 16)) { FRESH();
            moe_build_units(F, l, 4);
            pg8::MoeOrder S; S.A = (const char*)wsp<bf16_t>(F, WS_GACT); S.W = (const char*)(wsp<bf16_t>(F, WS_W2) + (size_t)l * 32 * 1024 * 1024); S.ul = (LAS const int*)(F.lds + MISC_OFF + 4096);
            S.wstride = (size_t)1024 * 1024 * 2; S.lda = 1024; S.ldb = 1024; S.K = 1024;
            pg8::EpiMoeY E{wsp<bf16_t>(F, WS_YB), F.in[34] + (size_t)l * 32 * 1024};
            pg8::gemm_phase(lds, S, E); __syncthreads(); SEAM(pb + 16);
        }
        if (ON(17) && IN(pb + 17)) { FRESH(); phase_ln_moe(F, F.in[35] + l * 1024, F.in[36] + l * 1024, l == DEPTH - 1); SEAM(pb + 17); }
    }
#undef IN
#undef SEAM
}

extern "C" void kernel_launch(void* const* d_in, const int* in_sizes, int n_in, void* d_out, int out_size, void* d_ws, size_t ws_size, hipStream_t stream) {
    static int grid = 0;
    if (grid == 0) {
        if (n_in != 37 || out_size != T_TOK * DM || ws_size < WS_END) { fprintf(stderr, "kernel_launch: unexpected shapes: n_in %d out %d ws %zu (need %zu)\n", n_in, out_size, ws_size, (size_t)WS_END); grid = -1; return; }
        int dev = 0, cus = 0, per_cu = 0;
        hipGetDevice(&dev); hipDeviceGetAttribute(&cus, hipDeviceAttributeMultiprocessorCount, dev);
        if (hipFuncSetAttribute((const void*)mk_fwd, hipFuncAttributeMaxDynamicSharedMemorySize, LDS_BYTES) != hipSuccess) { fprintf(stderr, "kernel_launch: hipFuncSetAttribute failed\n"); grid = -1; return; }
        if (hipOccupancyMaxActiveBlocksPerMultiprocessor(&per_cu, (const void*)mk_fwd, NTHREADS, LDS_BYTES) != hipSuccess || per_cu < 1) { fprintf(stderr, "kernel_launch: occupancy query says %d blocks per CU\n", per_cu); (void)hipGetLastError(); per_cu = 1; }
        grid = cus;
        if (grid > 256) grid = 256;
    }
    if (grid < 0) return;
    (void)hipMemsetAsync((char*)d_ws + WS_CTL, 0, CTL_BYTES, stream);
    Args a{};
    for (int i = 0; i < 37; ++i) a.in[i] = (const float*)d_in[i];
    a.out = (float*)d_out; a.ws = (unsigned char*)d_ws;
#if ONE_LAUNCH
    a.ph_lo = 0; a.ph_hi = NPHASES;
    void* kargs[] = {&a};
    hipError_t e = hipLaunchCooperativeKernel((const void*)mk_fwd, dim3(grid), dim3(NTHREADS), kargs, LDS_BYTES, stream);
    if (e != hipSuccess) fprintf(stderr, "kernel_launch: cooperative launch failed: %s (grid %d)\n", hipGetErrorString(e), grid);
#else
    for (int ph = 0; ph < NPHASES; ++ph) { a.ph_lo = ph; a.ph_hi = ph + 1; hipLaunchKernelGGL(mk_fwd, dim3(grid), dim3(NTHREADS), LDS_BYTES, stream, a); }
#endif
}
```

```cpp
#include <hip/hip_runtime.h>
#include <hip/hip_cooperative_groups.h>
#include <cstdio>
#include <cstdint>
namespace cg = cooperative_groups;

#ifndef ONE_LAUNCH
#define ONE_LAUNCH 1
#endif

#define LAS __attribute__((address_space(3)))
typedef unsigned short bf16_t;
typedef short bf16x8 __attribute__((ext_vector_type(8)));
typedef float f32x4 __attribute__((ext_vector_type(4)));
typedef float f32x2 __attribute__((ext_vector_type(2)));
typedef unsigned u32x4 __attribute__((ext_vector_type(4)));
typedef unsigned u32x2 __attribute__((ext_vector_type(2)));

constexpr int T_TOK = 16384, DM = 1024, SEQ = 2048, NBATCH = 8, DEPTH = 2;
constexpr int IN_COLS = 3848, NPROJ = 4096;
constexpr int RC0 = 2048;
constexpr int NEXP = 32, NMEM = 256;
constexpr int MOE_ROWS = 65536 + NEXP * 256;
constexpr int RECF = 388;
constexpr float DN_ALPHA = 1.4142135623730951f;
constexpr int NTHREADS = 512, NWAVES = 8;
constexpr int LDS_BYTES = 147456;
constexpr int GEMM_LDS = 131072;
constexpr int MISC_OFF = GEMM_LDS;

constexpr size_t MiB = 1u << 20;
constexpr size_t WS_CTL = 0;
constexpr size_t CTL_BYTES = 65536;
constexpr size_t WS_WIN = 1 * MiB;
constexpr size_t WS_WOUT = WS_WIN + 16 * MiB;
constexpr size_t WS_WQ = WS_WOUT + 4 * MiB;
constexpr size_t WS_WKV = WS_WQ + 4 * MiB;
constexpr size_t WS_WO = WS_WKV + 8 * MiB;
constexpr size_t WS_WLR = WS_WO + 4 * MiB;
constexpr size_t WS_W1 = WS_WLR + 2 * MiB;
constexpr size_t WS_W2 = WS_W1 + 256 * MiB;
constexpr size_t WS_H = WS_W2 + 128 * MiB;
constexpr size_t WS_HB = WS_H + 64 * MiB;
constexpr size_t WS_MEMB = WS_HB + 32 * MiB;
constexpr size_t WS_KBUF = WS_MEMB + 4 * MiB;
constexpr size_t WS_VTB = WS_KBUF + 8 * MiB;
constexpr size_t WS_CF = WS_VTB + 8 * MiB;
constexpr size_t WS_MIXED = WS_CF + 64 * MiB;
constexpr size_t WS_QB = WS_MIXED + 32 * MiB;
constexpr size_t WS_PB = WS_QB + 32 * MiB;
constexpr size_t WS_OB = WS_PB + 32 * MiB;
constexpr size_t WS_SMALL = WS_OB + 32 * MiB;
constexpr size_t SM_GATES = WS_SMALL;
constexpr size_t SM_BCUM = SM_GATES + 512 * 1024;
constexpr size_t SM_IGA = SM_BCUM + 256 * 1024;
constexpr size_t SM_BON = SM_IGA + 256 * 1024;
constexpr size_t SM_TOPI = SM_BON + 512 * 1024;
constexpr size_t SM_TOPG = SM_TOPI + 256 * 1024;
constexpr size_t SM_SLOT = SM_TOPG + 256 * 1024;
constexpr size_t SM_MLOC = SM_SLOT + 256 * 1024;
constexpr size_t SM_BLAST = SM_MLOC + 4096;
constexpr size_t SM_MPREV = SM_BLAST + 4096;
constexpr size_t SM_NLOC = SM_MPREV + 4096;
constexpr size_t WS_UNION = WS_SMALL + 8 * MiB;
constexpr size_t WS_PROJ = WS_UNION;
constexpr size_t WS_XLR = WS_PROJ + 128 * MiB;
constexpr size_t WS_LR = WS_XLR + 8 * MiB;
constexpr size_t WS_REC = WS_LR + 96 * MiB;
constexpr size_t WS_GV = WS_REC + 196 * MiB;
constexpr size_t WS_YR = WS_GV + 32 * MiB;
constexpr size_t WS_QC = WS_YR + 32 * MiB;
constexpr size_t WS_KC = WS_QC + 16 * MiB;
constexpr size_t WS_CLOC = WS_KC + 16 * MiB;
constexpr size_t WS_CPREV = WS_CLOC + 64 * MiB;
constexpr size_t WS_MIXEND = WS_CPREV + 36 * MiB;
constexpr size_t WS_XG = WS_UNION;
constexpr size_t WS_GACT = WS_XG + 144 * MiB;
constexpr size_t WS_YB = WS_GACT + 144 * MiB;
constexpr size_t WS_END = WS_MIXEND;
static_assert(WS_YB + 144 * MiB <= WS_MIXEND, "moe overlay fits");
static_assert((size_t)64 * 2048 * RECF * 4 <= 196 * MiB, "rec fits");
constexpr int CW_CNT = 0;
constexpr int CW_CUR = 64;
constexpr int CW_TILE = 128;

__device__ __forceinline__ unsigned f2bf(float f) { unsigned u = __builtin_bit_cast(unsigned, f); return (u + 0x7fffu + ((u >> 16) & 1u)) >> 16; }
__device__ __forceinline__ unsigned pk2(float lo, float hi) { return f2bf(lo) | (f2bf(hi) << 16); }
__device__ __forceinline__ float bf2f(unsigned b) { return __builtin_bit_cast(float, b << 16); }
__device__ __forceinline__ float bflo(unsigned w) { return __builtin_bit_cast(float, w << 16); }
__device__ __forceinline__ float bfhi(unsigned w) { return __builtin_bit_cast(float, w & 0xffff0000u); }
__device__ __forceinline__ unsigned cvt_pk_bf16(float lo, float hi) { unsigned r; asm volatile("v_cvt_pk_bf16_f32 %0, %1, %2" : "=v"(r) : "v"(lo), "v"(hi)); return r; }
__device__ __forceinline__ float wave_sum(float v) {
#pragma unroll
    for (int o = 1; o < 64; o <<= 1) v += __shfl_xor(v, o);
    return v;
}
__device__ __forceinline__ float wave_max(float v) {
#pragma unroll
    for (int o = 1; o < 64; o <<= 1) v = fmaxf(v, __shfl_xor(v, o));
    return v;
}
__device__ __forceinline__ float sigmoidf_(float x) { return 1.0f / (1.0f + __expf(-x)); }
__device__ __forceinline__ float softplusf_(float x) { return fmaxf(x, 0.f) + log1pf(__expf(-fabsf(x))); }
#define LDS_WAIT() asm volatile("s_waitcnt lgkmcnt(0)" ::: "memory")

namespace pg8 {
constexpr int BM = 256, BK = 64, HALF = 128, HTB = HALF * BK * 2, NXCD = 8, WGM = 8;
__device__ __forceinline__ int lds_byte(int r, int c) { const int st = (r >> 4) * 2 + (c >> 5), rr = r & 15, cc = c & 31, ob = rr * 64 + cc * 2; return st * 1024 + (ob ^ (((ob >> 9) & 1) << 5)); }
__device__ __forceinline__ void stage_rc(int b, int& R, int& C) { const int st = b / 1024, sb = b % 1024, swz = sb ^ (((sb >> 9) & 1) << 5); R = (st >> 1) * 16 + swz / 64; C = (st & 1) * 32 + (swz % 64) / 2; }
__device__ __forceinline__ int perm32(int rho) { const int n = rho >> 4, i = rho & 15; return 8 * (i >> 2) + 4 * n + (i & 3); }

struct Unit { int pm, pn, e; };

template <class Epi, class Sched>
__device__ __forceinline__ void gemm_phase(LAS unsigned char* lds, const Sched& S, const Epi& E) {
    int tid_ = threadIdx.x; asm volatile("" : "+v"(tid_)); const int tid = tid_, wid = __builtin_amdgcn_readfirstlane(tid >> 6), lane = tid & 63, wr = wid >> 2, wc = wid & 3, fr = lane & 15, fq = lane >> 4;
    const int K = S.K, nt = K / BK;
    unsigned voffA[2], voffB[2];
#pragma unroll
    for (int i = 0; i < 2; ++i) { int R, C; stage_rc(tid * 16 + i * 8192, R, C); const int Rb = Epi::PERM ? ((R & ~31) + perm32(R & 31)) : R;
        voffA[i] = (unsigned)(R * S.lda + C) * 2u; voffB[i] = (unsigned)(Rb * S.ldb + C) * 2u; }
    const size_t kstep = (size_t)(BK * 2);
    const size_t hstepA = (size_t)HALF * S.lda * 2, hstepB = (size_t)HALF * S.ldb * 2;
    const unsigned ldsw = (unsigned)wid * 1024u;
    const int aoff = lds_byte(wr * 64 + fr, fq * 8), boff = lds_byte(wc * 32 + fr, fq * 8);
#define PG8_SA(b, h) (((b) * 2 + (h)) * HTB)
#define PG8_SB(b, h) ((4 + (b) * 2 + (h)) * HTB)
#define PG8_STAGE(bufoff, gbase, voff) do { _Pragma("unroll") for (int _i = 0; _i < 2; ++_i) \
        __builtin_amdgcn_global_load_lds((const unsigned*)((const char*)(gbase) + (voff)[_i]), (LAS unsigned*)(lds + (bufoff) + ldsw + _i * 8192), 16, 0, 0); } while (0)
#define PG8_LDA(dst, b, h) do { _Pragma("unroll") for (int m = 0; m < 4; ++m) _Pragma("unroll") for (int k = 0; k < 2; ++k) dst[m][k] = *(const LAS bf16x8*)(lds + PG8_SA(b, h) + aoff + m * 2048 + k * 1024); } while (0)
#define PG8_LDB(dst, b, h) do { _Pragma("unroll") for (int n = 0; n < 2; ++n) _Pragma("unroll") for (int k = 0; k < 2; ++k) dst[n][k] = *(const LAS bf16x8*)(lds + PG8_SB(b, h) + boff + n * 2048 + k * 1024); } while (0)
#define PG8_MMA(ai, bj, At, Bt) do { __builtin_amdgcn_s_setprio(1); _Pragma("unroll") for (int m = 0; m < 4; ++m) _Pragma("unroll") for (int n = 0; n < 2; ++n) _Pragma("unroll") for (int k = 0; k < 2; ++k) \
        acc[ai][bj][m][n] = __builtin_amdgcn_mfma_f32_16x16x32_bf16(Bt[n][k], At[m][k], acc[ai][bj][m][n], 0, 0, 0); __builtin_amdgcn_s_setprio(0); } while (0)
#define PG8_WAIT_V(n) asm volatile("s_waitcnt vmcnt(" #n ")" ::: "memory")
#define PG8_WAIT_L(n) asm volatile("s_waitcnt lgkmcnt(" #n ")" ::: "memory")
#define PG8_BAR __builtin_amdgcn_s_barrier()
#define PG8_SCHED __builtin_amdgcn_sched_barrier(0)
    Unit cur, nxt; int ui = 0;
    if (!S.next(0, cur)) return;
    f32x4 acc[2][2][4][2];
#pragma unroll
    for (int a = 0; a < 2; ++a)
#pragma unroll
        for (int b = 0; b < 2; ++b)
#pragma unroll
            for (int m = 0; m < 4; ++m)
#pragma unroll
                for (int n = 0; n < 2; ++n) acc[a][b][m][n] = (f32x4){0.f, 0.f, 0.f, 0.f};
    bf16x8 At[4][2], B0[2][2], B1[2][2];
    const char* cA = S.aptr(cur); const char* cB = S.bptr(cur);
    PG8_STAGE(PG8_SB(0, 0), cB, voffB); PG8_STAGE(PG8_SA(0, 0), cA, voffA); PG8_STAGE(PG8_SB(0, 1), cB + hstepB, voffB); PG8_STAGE(PG8_SA(0, 1), cA + hstepA, voffA);
    if (wr == 1) PG8_BAR;
    PG8_WAIT_V(4); PG8_BAR;
    PG8_STAGE(PG8_SB(1, 0), cB + kstep, voffB); PG8_STAGE(PG8_SA(1, 0), cA + kstep, voffA); PG8_STAGE(PG8_SB(1, 1), cB + hstepB + kstep, voffB);
    PG8_WAIT_V(6); PG8_BAR;
    for (;;) {
        const bool has_next = S.next(ui + 1, nxt);
        const char* nA = has_next ? S.aptr(nxt) : cA; const char* nB = has_next ? S.bptr(nxt) : cB;
        for (int t = 0; t < nt; t += 2) {
            const bool last = (t == nt - 2);
            const char* a1 = cA + (size_t)(t + 1) * kstep;
            const char* a2 = last ? nA : cA + (size_t)(t + 2) * kstep; const char* b2 = last ? nB : cB + (size_t)(t + 2) * kstep;
            const char* a3 = a2 + kstep; const char* b3 = b2 + kstep;
            PG8_LDB(B0, 0, 0); PG8_SCHED; PG8_LDA(At, 0, 0); PG8_STAGE(PG8_SA(1, 1), a1 + hstepA, voffA);
            PG8_WAIT_L(8); PG8_BAR; PG8_WAIT_L(0); PG8_MMA(0, 0, At, B0); PG8_BAR; PG8_SCHED;
            PG8_LDB(B1, 0, 1); PG8_STAGE(PG8_SB(0, 0), b2, voffB);
            PG8_BAR; PG8_WAIT_L(0); PG8_MMA(0, 1, At, B1); PG8_BAR;
            PG8_LDA(At, 0, 1); PG8_STAGE(PG8_SA(0, 0), a2, voffA);
            PG8_BAR; PG8_WAIT_L(0); PG8_MMA(1, 0, At, B0); PG8_BAR; PG8_SCHED;
            PG8_STAGE(PG8_SB(0, 1), b2 + hstepB, voffB);
            PG8_WAIT_V(6); PG8_BAR; PG8_MMA(1, 1, At, B1); PG8_BAR;
            PG8_LDB(B0, 1, 0); PG8_SCHED; PG8_LDA(At, 1, 0); PG8_STAGE(PG8_SA(0, 1), a2 + hstepA, voffA);
            PG8_WAIT_L(8); PG8_BAR; PG8_WAIT_L(0); PG8_MMA(0, 0, At, B0); PG8_BAR; PG8_SCHED;
            PG8_LDB(B1, 1, 1); PG8_STAGE(PG8_SB(1, 0), b3, voffB);
            PG8_BAR; PG8_WAIT_L(0); PG8_MMA(0, 1, At, B1); PG8_BAR;
            PG8_LDA(At, 1, 1); PG8_STAGE(PG8_SA(1, 0), a3, voffA);
            PG8_BAR; PG8_WAIT_L(0); PG8_MMA(1, 0, At, B0); PG8_BAR; PG8_SCHED;
            PG8_STAGE(PG8_SB(1, 1), b3 + hstepB, voffB);
            PG8_WAIT_V(6); PG8_BAR; PG8_MMA(1, 1, At, B1); PG8_BAR;
        }
        if constexpr (!Epi::AFTER_DRAIN) { int fr_ = fr, fq_ = fq; asm volatile("" : "+v"(fr_), "+v"(fq_)); E(acc, cur, wr, wc, fr_, fq_); }
        if (!has_next) break;
#pragma unroll
        for (int a = 0; a < 2; ++a)
#pragma unroll
            for (int b = 0; b < 2; ++b)
#pragma unroll
                for (int m = 0; m < 4; ++m)
#pragma unroll
                    for (int n = 0; n < 2; ++n) acc[a][b][m][n] = (f32x4){0.f, 0.f, 0.f, 0.f};
        cur = nxt; cA = nA; cB = nB; ++ui;
    }
    PG8_WAIT_V(0);
    if (wr == 0) PG8_BAR;
    PG8_BAR;
    if constexpr (Epi::AFTER_DRAIN) { int fr_ = fr, fq_ = fq; asm volatile("" : "+v"(fr_), "+v"(fq_)); E.fused(acc, cur, wr, wc, fr_, fq_, lds, wid, lane); }
#undef PG8_SA
#undef PG8_SB
#undef PG8_STAGE
#undef PG8_LDA
#undef PG8_LDB
#undef PG8_MMA
#undef PG8_WAIT_V
#undef PG8_WAIT_L
#undef PG8_BAR
#undef PG8_SCHED
}

struct DenseOrder {
    const char* A; const char* Bt; int lda, ldb, K; int nM, nN, nwg, G, c;
    __device__ void init(const void* A_, const void* Bt_, int M, int N, int K_, int lda_, int ldb_, int G_, int c_) { A = (const char*)A_; Bt = (const char*)Bt_; K = K_; lda = lda_; ldb = ldb_; nM = M / BM; nN = N / BM; nwg = nM * nN; G = G_; c = c_; }
    __device__ bool next(int i, Unit& u) const {
        const long L = (long)i * G + c; if (L >= nwg) return false;
        int wgid = (int)L; { const int q = nwg / NXCD, r = nwg % NXCD, xcd = wgid % NXCD, off = wgid / NXCD; wgid = (xcd < r ? xcd * (q + 1) : r * (q + 1) + (xcd - r) * q) + off; }
        const int nig = WGM * nN, gid = wgid / nig, fm = gid * WGM, gsz = (nM - fm) < WGM ? (nM - fm) : WGM;
        u.pm = fm + ((wgid % nig) % gsz); u.pn = (wgid % nig) / gsz; u.e = 0; return true;
    }
    __device__ __forceinline__ const char* aptr(const Unit& u) const { return A + (size_t)u.pm * BM * lda * 2; }
    __device__ __forceinline__ const char* bptr(const Unit& u) const { return Bt + (size_t)u.pn * BM * ldb * 2; }
};
struct KvOrder {
    const char* memb; const char* wkv; int lda, ldb, K, G, c;
    __device__ bool next(int i, Unit& u) const {
        const int L = i * G + c; if (L >= 128) return false;
        const int layer = L >> 6, rem = L & 63;
        if (rem < 32) { u.pm = rem >> 2; u.pn = rem & 3; u.e = layer * 2; }
        else { u.pm = (rem - 32) >> 3; u.pn = (rem - 32) & 7; u.e = layer * 2 + 1; }
        return true;
    }
    __device__ __forceinline__ const char* aptr(const Unit& u) const {
        const int layer = u.e >> 1;
        return (u.e & 1) ? wkv + ((size_t)layer * 2048 + 1024 + (size_t)u.pm * 256) * 2048 : memb + (size_t)u.pm * 256 * 2048;
    }
    __device__ __forceinline__ const char* bptr(const Unit& u) const {
        const int layer = u.e >> 1;
        return (u.e & 1) ? memb + (size_t)u.pn * 256 * 2048 : wkv + ((size_t)layer * 2048 + (size_t)u.pn * 256) * 2048;
    }
};
struct SOrder {
    const char* Q; const char* Kb; int lda, ldb, K, G, c;
    __device__ bool next(int i, Unit& u) const { const int L = i * G + c; if (L >= 256) return false; u.pm = L & 7; u.pn = 0; u.e = L >> 3; return true; }
    __device__ __forceinline__ const char* aptr(const Unit& u) const { const int b = u.e >> 2, hd = u.e & 3; return Q + (((size_t)b * 2048 + (size_t)u.pm * 256) * 1024 + hd * 256) * 2; }
    __device__ __forceinline__ const char* bptr(const Unit& u) const { const int b = u.e >> 2, hd = u.e & 3; return Kb + (((size_t)b * 256) * 1024 + hd * 256) * 2; }
};
struct PvOrder {
    const char* P; const char* Vt; int lda, ldb, K, G, c;
    __device__ bool next(int i, Unit& u) const { const int L = i * G + c; if (L >= 256) return false; u.pm = L & 7; u.pn = 0; u.e = L >> 3; return true; }
    __device__ __forceinline__ const char* aptr(const Unit& u) const { return P + (((size_t)u.e * 2048 + (size_t)u.pm * 256) * 256) * 2; }
    __device__ __forceinline__ const char* bptr(const Unit& u) const { const int b = u.e >> 2, hd = u.e & 3; return Vt + (((size_t)hd * 256) * 2048 + (size_t)b * 256) * 2; }
};
struct MoeOrder {
    const char* A; const char* W; LAS const int* ul; size_t wstride; int lda, ldb, K;
    __device__ bool next(int i, Unit& u) const {
        if (i >= 16) return false;
        const int pm = __builtin_amdgcn_readfirstlane(ul[3 * i]); if (pm < 0) return false;
        u.pm = pm; u.pn = __builtin_amdgcn_readfirstlane(ul[3 * i + 1]); u.e = __builtin_amdgcn_readfirstlane(ul[3 * i + 2]); return true;
    }
    __device__ __forceinline__ const char* aptr(const Unit& u) const { return A + (size_t)u.pm * 256 * lda * 2; }
    __device__ __forceinline__ const char* bptr(const Unit& u) const { return W + (size_t)u.e * wstride + (size_t)u.pn * 256 * ldb * 2; }
};

struct EpiF32 {
    static constexpr bool PERM = false, AFTER_DRAIN = false;
    float* C; int ldc;
    __device__ __forceinline__ void operator()(const f32x4 (&acc)[2][2][4][2], const Unit& u, int wr, int wc, int fr, int fq) const {
        const int row0 = u.pm * BM + wr * 64 + fr, col0 = u.pn * BM + wc * 32 + 4 * fq;
#pragma unroll
        for (int ai = 0; ai < 2; ++ai)
#pragma unroll
            for (int m = 0; m < 4; ++m) { float* rowp = C + (size_t)(row0 + ai * HALF + m * 16) * ldc + col0;
#pragma unroll
                for (int bj = 0; bj < 2; ++bj)
#pragma unroll
                    for (int n = 0; n < 2; ++n) *(f32x4*)(rowp + bj * HALF + n * 16) = acc[ai][bj][m][n]; }
    }
};
__device__ __forceinline__ void store_bf16_tile(const f32x4 (&acc)[2][2][4][2], bf16_t* base, int ldc, float sc, int wr, int wc, int fr, int fq) {
    const int row0 = wr * 64 + fr, col0 = wc * 32 + 8 * fq;
#pragma unroll
    for (int ai = 0; ai < 2; ++ai)
#pragma unroll
        for (int m = 0; m < 4; ++m) { bf16_t* rowp = base + (size_t)(row0 + ai * HALF + m * 16) * ldc + col0;
#pragma unroll
            for (int bj = 0; bj < 2; ++bj) { const f32x4 v0 = acc[ai][bj][m][0] * sc, v1 = acc[ai][bj][m][1] * sc;
                u32x4 w; w.x = cvt_pk_bf16(v0[0], v0[1]); w.y = cvt_pk_bf16(v0[2], v0[3]); w.z = cvt_pk_bf16(v1[0], v1[1]); w.w = cvt_pk_bf16(v1[2], v1[3]);
                *(u32x4*)(rowp + bj * HALF) = w; } }
}
struct EpiBf16 {
    static constexpr bool PERM = true, AFTER_DRAIN = false;
    bf16_t* O; int ldc; float scale;
    __device__ __forceinline__ void operator()(const f32x4 (&acc)[2][2][4][2], const Unit& u, int wr, int wc, int fr, int fq) const {
        store_bf16_tile(acc, O + (size_t)u.pm * BM * ldc + u.pn * BM, ldc, scale, wr, wc, fr, fq);
    }
};
struct EpiProj {
    static constexpr bool PERM = true, AFTER_DRAIN = false;
    bf16_t* O; float* gates;
    __device__ __forceinline__ void operator()(const f32x4 (&acc)[2][2][4][2], const Unit& u, int wr, int wc, int fr, int fq) const {
        store_bf16_tile(acc, O + (size_t)u.pm * BM * NPROJ + u.pn * BM, NPROJ, 1.0f, wr, wc, fr, fq);
        if (u.pn == 15 && wc == 0 && fq == 0) {
#pragma unroll
            for (int ai = 0; ai < 2; ++ai)
#pragma unroll
                for (int m = 0; m < 4; ++m) { float* g = gates + (size_t)(u.pm * BM + ai * HALF + wr * 64 + m * 16 + fr) * 8;
                    *(f32x4*)g = acc[ai][0][m][0]; *(f32x4*)(g + 4) = acc[ai][0][m][1]; }
        }
    }
};
struct EpiKv {
    static constexpr bool PERM = true, AFTER_DRAIN = false;
    bf16_t* Kb; bf16_t* Vt;
    __device__ __forceinline__ void operator()(const f32x4 (&acc)[2][2][4][2], const Unit& u, int wr, int wc, int fr, int fq) const {
        const int layer = u.e >> 1;
        if (u.e & 1) store_bf16_tile(acc, Vt + (size_t)layer * 1024 * 2048 + (size_t)u.pm * BM * 2048 + u.pn * BM, 2048, 1.0f, wr, wc, fr, fq);
        else store_bf16_tile(acc, Kb + (size_t)layer * 2048 * 1024 + (size_t)u.pm * BM * 1024 + u.pn * BM, 1024, 1.0f, wr, wc, fr, fq);
    }
};
struct EpiPv {
    static constexpr bool PERM = true, AFTER_DRAIN = false;
    bf16_t* O;
    __device__ __forceinline__ void operator()(const f32x4 (&acc)[2][2][4][2], const Unit& u, int wr, int wc, int fr, int fq) const {
        const int b = u.e >> 2, hd = u.e & 3;
        store_bf16_tile(acc, O + ((size_t)b * 2048 + (size_t)u.pm * 256) * 1024 + hd * 256, 1024, 1.0f, wr, wc, fr, fq);
    }
};
struct EpiSoftmax {
    static constexpr bool PERM = true, AFTER_DRAIN = true;
    bf16_t* P;
    __device__ __forceinline__ void fused(f32x4 (&acc)[2][2][4][2], const Unit& u, int wr, int wc, int fr, int fq, LAS unsigned char* lds, int wid, int lane) const {
        LAS f32x2* tab = (LAS f32x2*)lds;
#pragma unroll
        for (int ai = 0; ai < 2; ++ai)
#pragma unroll
            for (int m = 0; m < 4; ++m) {
                float mx = -3.0e38f;
#pragma unroll
                for (int bj = 0; bj < 2; ++bj)
#pragma unroll
                    for (int n = 0; n < 2; ++n) { const f32x4 x = acc[ai][bj][m][n]; mx = fmaxf(mx, fmaxf(fmaxf(x[0], x[1]), fmaxf(x[2], x[3]))); }
                mx = fmaxf(mx, __shfl_xor(mx, 16)); mx = fmaxf(mx, __shfl_xor(mx, 32));
                float s = 0.f;
#pragma unroll
                for (int bj = 0; bj < 2; ++bj)
#pragma unroll
                    for (int n = 0; n < 2; ++n) { const f32x4 x = acc[ai][bj][m][n]; s += (__expf(x[0] - mx) + __expf(x[1] - mx)) + (__expf(x[2] - mx) + __expf(x[3] - mx)); }
                s += __shfl_xor(s, 16); s += __shfl_xor(s, 32);
                if (fq == 0) tab[(ai * HALF + wr * 64 + m * 16 + fr) * 4 + wc] = (f32x2){mx, s};
            }
        LDS_WAIT(); __builtin_amdgcn_s_barrier(); asm volatile("" ::: "memory");
        bf16_t* base = P + ((size_t)u.e * 2048 + (size_t)u.pm * 256) * 256;
#pragma unroll
        for (int ai = 0; ai < 2; ++ai)
#pragma unroll
            for (int m = 0; m < 4; ++m) { const int r = ai * HALF + wr * 64 + m * 16 + fr;
                const f32x2 p0 = tab[r * 4 + 0], p1 = tab[r * 4 + 1], p2 = tab[r * 4 + 2], p3 = tab[r * 4 + 3];
                const float M = fmaxf(fmaxf(p0.x, p1.x), fmaxf(p2.x, p3.x));
                const float ssum = p0.y * __expf(p0.x - M) + p1.y * __expf(p1.x - M) + p2.y * __expf(p2.x - M) + p3.y * __expf(p3.x - M);
                const float inv = 1.0f / ssum;
                bf16_t* rowp = base + (size_t)r * 256 + wc * 32 + 8 * fq;
#pragma unroll
                for (int bj = 0; bj < 2; ++bj) { const f32x4 x0 = acc[ai][bj][m][0], x1 = acc[ai][bj][m][1];
                    u32x4 w; w.x = cvt_pk_bf16(__expf(x0[0] - M) * inv, __expf(x0[1] - M) * inv); w.y = cvt_pk_bf16(__expf(x0[2] - M) * inv, __expf(x0[3] - M) * inv);
                    w.z = cvt_pk_bf16(__expf(x1[0] - M) * inv, __expf(x1[1] - M) * inv); w.w = cvt_pk_bf16(__expf(x1[2] - M) * inv, __expf(x1[3] - M) * inv);
                    *(u32x4*)(rowp + bj * HALF) = w; } }
        LDS_WAIT(); __builtin_amdgcn_s_barrier(); asm volatile("" ::: "memory");
    }
};
struct EpiSwiglu {
    static constexpr bool PERM = true, AFTER_DRAIN = false;
    bf16_t* G; const float* b1;
    __device__ __forceinline__ void operator()(const f32x4 (&acc)[2][2][4][2], const Unit& u, int wr, int wc, int fr, int fq) const {
        const int cin = wc * 32 + 8 * fq;
        const float* bg = b1 + (size_t)u.e * 2048 + u.pn * 128 + cin; const float* bu = bg + 1024;
        const f32x4 g0 = *(const f32x4*)bg, g1 = *(const f32x4*)(bg + 4), u0 = *(const f32x4*)bu, u1 = *(const f32x4*)(bu + 4);
#pragma unroll
        for (int ai = 0; ai < 2; ++ai)
#pragma unroll
            for (int m = 0; m < 4; ++m) {
                bf16_t* rowp = G + (size_t)(u.pm * BM + ai * HALF + wr * 64 + m * 16 + fr) * 1024 + u.pn * 128 + cin;
                float o[8];
#pragma unroll
                for (int n = 0; n < 2; ++n) { const f32x4 ga = acc[ai][0][m][n] + (n ? g1 : g0), up = acc[ai][1][m][n] + (n ? u1 : u0);
#pragma unroll
                    for (int j = 0; j < 4; ++j) { const float gt = fminf(ga[j], 7.0f), uu = fminf(fmaxf(up[j], -7.0f), 7.0f);
                        const float glu = gt / (1.0f + __expf(-1.702f * gt)); o[n * 4 + j] = (uu + 1.0f) * glu; } }
                u32x4 w; w.x = cvt_pk_bf16(o[0], o[1]); w.y = cvt_pk_bf16(o[2], o[3]); w.z = cvt_pk_bf16(o[4], o[5]); w.w = cvt_pk_bf16(o[6], o[7]);
                *(u32x4*)rowp = w; }
    }
};
struct EpiMoeY {
    static constexpr bool PERM = true, AFTER_DRAIN = false;
    bf16_t* Y; const float* b2;
    __device__ __forceinline__ void operator()(const f32x4 (&acc)[2][2][4][2], const Unit& u, int wr, int wc, int fr, int fq) const {
        const int col0 = u.pn * BM + wc * 32 + 8 * fq;
        f32x4 bv[2][2];
#pragma unroll
        for (int bj = 0; bj < 2; ++bj)
#pragma unroll
            for (int n = 0; n < 2; ++n) bv[bj][n] = *(const f32x4*)(b2 + (size_t)u.e * 1024 + col0 + bj * HALF + 4 * n);
#pragma unroll
        for (int ai = 0; ai < 2; ++ai)
#pragma unroll
            for (int m = 0; m < 4; ++m) { bf16_t* rowp = Y + (size_t)(u.pm * BM + ai * HALF + wr * 64 + m * 16 + fr) * 1024 + col0;
#pragma unroll
                for (int bj = 0; bj < 2; ++bj) { const f32x4 v0 = acc[ai][bj][m][0] + bv[bj][0], v1 = acc[ai][bj][m][1] + bv[bj][1];
                    u32x4 w; w.x = cvt_pk_bf16(v0[0], v0[1]); w.y = cvt_pk_bf16(v0[2], v0[3]); w.z = cvt_pk_bf16(v1[0], v1[1]); w.w = cvt_pk_bf16(v1[2], v1[3]);
                    *(u32x4*)(rowp + bj * HALF) = w; } }
    }
};
}

struct Args { const float* in[37]; float* out; unsigned char* ws; int ph_lo, ph_hi; };
constexpr int TAB_OFF = MISC_OFF + 8192;
struct InTab {
    LAS const volatile unsigned* t;
    __device__ __forceinline__ const void* get(int k) const { unsigned lo = t[2 * k], hi = t[2 * k + 1]; lo = __builtin_amdgcn_readfirstlane(lo); hi = __builtin_amdgcn_readfirstlane(hi); return (const void*)(((unsigned long long)hi << 32) | lo); }
    __device__ __forceinline__ const float* operator[](int k) const { return (const float*)get(k); }
};
struct Ctx {
    LAS unsigned char* lds; int tid, lane, wave, blk, G, gw, ngw;
    InTab in; float* out; unsigned char* ws;
};
template <class Tp> __device__ __forceinline__ Tp* wsp(const Ctx& F, size_t off) { return (Tp*)(F.ws + off); }

__device__ __forceinline__ void ln_row_store(f32x4 (&v)[4], const float* g, const float* b, float* hrow, bf16_t* hbrow, int lane) {
    float s = 0.f;
#pragma unroll
    for (int j = 0; j < 4; ++j) s += (v[j][0] + v[j][1]) + (v[j][2] + v[j][3]);
    const float mean = wave_sum(s) * (1.0f / 1024.0f); float s2 = 0.f;
#pragma unroll
    for (int j = 0; j < 4; ++j) { v[j] = v[j] - mean; s2 += (v[j][0] * v[j][0] + v[j][1] * v[j][1]) + (v[j][2] * v[j][2] + v[j][3] * v[j][3]); }
    const float rstd = 1.0f / sqrtf(wave_sum(s2) * (1.0f / 1024.0f) + 1e-5f);
#pragma unroll
    for (int j = 0; j < 4; ++j) {
        const f32x4 gg = *(const f32x4*)(g + 256 * j + 4 * lane), bb = *(const f32x4*)(b + 256 * j + 4 * lane);
        const f32x4 o = v[j] * rstd * gg + bb;
        *(f32x4*)(hrow + 256 * j + 4 * lane) = o;
        if (hbrow) { u32x2 w; w.x = pk2(o[0], o[1]); w.y = pk2(o[2], o[3]); *(u32x2*)(hbrow + 256 * j + 4 * lane) = w; }
    }
}

__device__ __forceinline__ int map_row(int kind, int n) {
    if (kind == 1) return n < 2048 ? n : (n < 2056 ? 3840 + (n - 2048) : n - 8);
    if (kind == 2) { const int j = n & 1023; return (j >> 7) * 256 + ((n >> 10) << 7) + (j & 127); }
    return n;
}
__device__ __forceinline__ void transpose_item(const float* W, int N, bf16_t* WT, int kind, LAS float* scr, int item, int lane) {
    const int nblk = (N + 31) >> 5, kb = item / nblk, nb = item % nblk, k0 = 64 * kb, n0 = 32 * nb;
    const int nn = n0 + (lane & 31); const bool ok = nn < N;
#pragma unroll 8
    for (int i = 0; i < 32; ++i) { const int kk = 2 * i + (lane >> 5); scr[kk * 33 + (lane & 31)] = ok ? W[(size_t)(k0 + kk) * N + nn] : 0.f; }
    LDS_WAIT(); asm volatile("" ::: "memory");
    const int c = lane & 7;
#pragma unroll
    for (int j = 0; j < 4; ++j) { const int n = (lane >> 3) + 8 * j; const LAS float* s = scr + (8 * c) * 33 + n;
        if (n0 + n < N) { u32x4 o; o.x = pk2(s[0 * 33], s[1 * 33]); o.y = pk2(s[2 * 33], s[3 * 33]); o.z = pk2(s[4 * 33], s[5 * 33]); o.w = pk2(s[6 * 33], s[7 * 33]);
            *(u32x4*)(WT + (size_t)map_row(kind, n0 + n) * 1024 + k0 + 8 * c) = o; } }
    LDS_WAIT(); asm volatile("" ::: "memory");
}
__device__ __forceinline__ void phase_prologue(const Ctx& F) {
    LAS float* scr = (LAS float*)(F.lds + F.wave * 16384);
    constexpr int I_IN = 16 * 121, I_SQ = 16 * 32, I_KV = 16 * 64, I_W1 = 16 * 64, I_W2 = 16 * 32;
    constexpr int PER_LAYER = I_IN + 3 * I_SQ + I_KV + 32 * I_W1 + 32 * I_W2;
    const float* p_win = F.in[4]; const float* p_wout = F.in[21]; const float* p_wq = F.in[24]; const float* p_wkv = F.in[25]; const float* p_wo = F.in[26]; const float* p_w1 = F.in[31]; const float* p_w2 = F.in[33];
    for (int it = F.gw; it < 2 * PER_LAYER; it += F.ngw) {
        const int l = it / PER_LAYER; int r = it % PER_LAYER;
        if (r < I_IN) { transpose_item(p_win + (size_t)l * 1024 * IN_COLS, IN_COLS, wsp<bf16_t>(F, WS_WIN) + (size_t)l * 4096 * 1024, 1, scr, r, F.lane); continue; } r -= I_IN;
        if (r < I_SQ) { transpose_item(p_wout + (size_t)l * 1024 * 1024, 1024, wsp<bf16_t>(F, WS_WOUT) + (size_t)l * 1024 * 1024, 0, scr, r, F.lane); continue; } r -= I_SQ;
        if (r < I_SQ) { transpose_item(p_wq + (size_t)l * 1024 * 1024, 1024, wsp<bf16_t>(F, WS_WQ) + (size_t)l * 1024 * 1024, 0, scr, r, F.lane); continue; } r -= I_SQ;
        if (r < I_KV) { transpose_item(p_wkv + (size_t)l * 1024 * 2048, 2048, wsp<bf16_t>(F, WS_WKV) + (size_t)l * 2048 * 1024, 0, scr, r, F.lane); continue; } r -= I_KV;
        if (r < I_SQ) { transpose_item(p_wo + (size_t)l * 1024 * 1024, 1024, wsp<bf16_t>(F, WS_WO) + (size_t)l * 1024 * 1024, 0, scr, r, F.lane); continue; } r -= I_SQ;
        if (r < 32 * I_W1) { const int e = r / I_W1; transpose_item(p_w1 + ((size_t)l * 32 + e) * 1024 * 2048, 2048, wsp<bf16_t>(F, WS_W1) + ((size_t)l * 32 + e) * 2048 * 1024, 2, scr, r % I_W1, F.lane); continue; } r -= 32 * I_W1;
        { const int e = r / I_W2; transpose_item(p_w2 + ((size_t)l * 32 + e) * 1024 * 1024, 1024, wsp<bf16_t>(F, WS_W2) + ((size_t)l * 32 + e) * 1024 * 1024, 0, scr, r % I_W2, F.lane); }
    }
    const int gt = F.blk * NTHREADS + F.tid, ngt = F.G * NTHREADS;
    for (int i = gt; i < 2 * 248 * 128; i += ngt) { const int l = i / (248 * 128), r = i % (248 * 128); *(u32x4*)(wsp<bf16_t>(F, WS_WIN) + ((size_t)l * 4096 + 3848) * 1024 + (size_t)r * 8) = (u32x4){0u, 0u, 0u, 0u}; }
    const float* pw2 = F.in[12]; const float* pa2 = F.in[14]; const float* pg2 = F.in[15];
    for (int i = gt; i < 2 * 1536 * 256; i += ngt) {
        const int l = i / (1536 * 256), r = i % (1536 * 256), n = r >> 8, k = r & 255; float v = 0.f;
        if (n < 512) { if (k < 64) v = pw2[((size_t)l * 64 + k) * 512 + n]; }
        else if (n < 1024) { if (k >= 64 && k < 128) v = pa2[((size_t)l * 64 + (k - 64)) * 512 + (n - 512)]; }
        else { if (k >= 128) v = pg2[((size_t)l * 128 + (k - 128)) * 512 + (n - 1024)]; }
        wsp<bf16_t>(F, WS_WLR)[i] = (bf16_t)f2bf(v);
    }
    const f32x4* pmem = (const f32x4*)F.in[1];
    for (int i = gt; i < 2048 * 1024 / 4; i += ngt) { const f32x4 v = pmem[i]; u32x2 w; w.x = pk2(v[0], v[1]); w.y = pk2(v[2], v[3]); ((u32x2*)wsp<bf16_t>(F, WS_MEMB))[i] = w; }
    const float* px = F.in[0]; const float* pg0 = F.in[2]; const float* pb0 = F.in[3];
    for (int m = F.gw; m < T_TOK; m += F.ngw) {
        f32x4 v[4]; const float* xr = px + (size_t)m * DM;
#pragma unroll
        for (int j = 0; j < 4; ++j) v[j] = *(const f32x4*)(xr + 256 * j + 4 * F.lane);
        ln_row_store(v, pg0, pb0, wsp<float>(F, WS_H) + (size_t)m * DM, wsp<bf16_t>(F, WS_HB) + (size_t)m * DM, F.lane);
    }
}

__device__ __forceinline__ void phase_ln_add(const Ctx& F, const float* g, const float* b) {
    for (int m = F.gw; m < T_TOK; m += F.ngw) {
        f32x4 v[4]; const float* hr = wsp<float>(F, WS_H) + (size_t)m * DM; const float* cr = wsp<float>(F, WS_CF) + (size_t)m * DM;
#pragma unroll
        for (int j = 0; j < 4; ++j) v[j] = *(const f32x4*)(hr + 256 * j + 4 * F.lane) * DN_ALPHA + *(const f32x4*)(cr + 256 * j + 4 * F.lane);
        ln_row_store(v, g, b, wsp<float>(F, WS_H) + (size_t)m * DM, wsp<bf16_t>(F, WS_HB) + (size_t)m * DM, F.lane);
    }
}
__device__ __forceinline__ void phase_ln_moe(const Ctx& F, const float* g, const float* b, bool last) {
    const int* slot = wsp<int>(F, SM_SLOT); const float* tg = wsp<float>(F, SM_TOPG); const bf16_t* Y = wsp<bf16_t>(F, WS_YB);
    for (int m = F.gw; m < T_TOK; m += F.ngw) {
        f32x4 v[4]; const float* hr = wsp<float>(F, WS_H) + (size_t)m * DM;
#pragma unroll
        for (int j = 0; j < 4; ++j) v[j] = *(const f32x4*)(hr + 256 * j + 4 * F.lane) * DN_ALPHA;
#pragma unroll
        for (int k = 0; k < 4; ++k) { const int sl = slot[m * 4 + k]; const float gk = tg[m * 4 + k]; const bf16_t* yr = Y + (size_t)sl * DM;
#pragma unroll
            for (int j = 0; j < 4; ++j) { const u32x2 w = *(const u32x2*)(yr + 256 * j + 4 * F.lane);
                v[j][0] += gk * bflo(w.x); v[j][1] += gk * bfhi(w.x); v[j][2] += gk * bflo(w.y); v[j][3] += gk * bfhi(w.y); } }
        float* dst = last ? F.out + (size_t)m * DM : wsp<float>(F, WS_H) + (size_t)m * DM;
        ln_row_store(v, g, b, dst, last ? (bf16_t*)nullptr : wsp<bf16_t>(F, WS_HB) + (size_t)m * DM, F.lane);
    }
}

__device__ __forceinline__ void phase_xlr(const Ctx& F, int l) {
    const bf16_t* proj = wsp<bf16_t>(F, WS_PROJ); bf16_t* xlr = wsp<bf16_t>(F, WS_XLR); const float* mu = F.in[10] + (size_t)l * 1792 + 1536;
    const int gt = F.blk * NTHREADS + F.tid, ngt = F.G * NTHREADS;
    for (int i = gt; i < T_TOK * 32; i += ngt) {
        const int t = i >> 5, c8 = (i & 31) * 8;
        const u32x4 p = *(const u32x4*)(proj + (size_t)t * NPROJ + RC0 + 1536 + c8);
        u32x4 q = (u32x4){0u, 0u, 0u, 0u}; if ((t & (SEQ - 1)) != 0) q = *(const u32x4*)(proj + (size_t)(t - 1) * NPROJ + RC0 + 1536 + c8);
        float o[8];
#pragma unroll
        for (int j = 0; j < 4; ++j) { const float a0 = bflo(p[j]), a1 = bfhi(p[j]), b0 = bflo(q[j]), b1 = bfhi(q[j]);
            o[2 * j] = a0 + (b0 - a0) * mu[c8 + 2 * j]; o[2 * j + 1] = a1 + (b1 - a1) * mu[c8 + 2 * j + 1]; }
#pragma unroll
        for (int j = 0; j < 8; ++j) { if (c8 < 64) o[j] = tanhf(o[j]); else if (c8 >= 128) o[j] = sigmoidf_(o[j]); }
        u32x4 w; w.x = pk2(o[0], o[1]); w.y = pk2(o[2], o[3]); w.z = pk2(o[4], o[5]); w.w = pk2(o[6], o[7]);
        *(u32x4*)(xlr + (size_t)t * 256 + c8) = w;
    }
}

__device__ __forceinline__ void phase_rwkv_prep(const Ctx& F, int l) {
    const bf16_t* proj = wsp<bf16_t>(F, WS_PROJ); const float* lr = wsp<float>(F, WS_LR); float* rec = wsp<float>(F, WS_REC); float* gv = wsp<float>(F, WS_GV); float* bon = wsp<float>(F, SM_BON);
    const float* mu = F.in[10] + (size_t)l * 1792; const float* w0 = F.in[11] + l * 512; const float* a0 = F.in[13] + l * 512;
    const float* pkk = F.in[16] + l * 512; const float* pka = F.in[17] + l * 512; const float* prk = F.in[18] + l * 512;
    for (int item = F.gw; item < T_TOK * 8; item += F.ngw) {
        const int t = item >> 3, h = item & 7, c = h * 64 + F.lane, s = t & (SEQ - 1), bh = (t >> 11) * 8 + h;
        const bf16_t* pr = proj + (size_t)t * NPROJ + RC0; const bool hasp = s != 0;
        float xr = bf2f(pr[c]), xk = bf2f(pr[512 + c]), xv = bf2f(pr[1024 + c]);
        const float yr = hasp ? bf2f(pr[c - NPROJ]) : 0.f, yk = hasp ? bf2f(pr[512 + c - NPROJ]) : 0.f, yv = hasp ? bf2f(pr[1024 + c - NPROJ]) : 0.f;
        xr = xr + (yr - xr) * mu[c]; xk = xk + (yk - xk) * mu[512 + c]; xv = xv + (yv - xv) * mu[1024 + c];
        const float* lrow = lr + (size_t)t * 1536;
        const float wpre = w0[c] + lrow[c];
        const float wlog = -softplusf_(-wpre) - 0.5f;
        const float d = __expf(-__expf(wlog));
        const float a = sigmoidf_(a0[c] + lrow[512 + c]);
        const float g = lrow[1024 + c];
        float kk = xk * pkk[c];
        const float nrm = sqrtf(wave_sum(kk * kk)); kk = kk / fmaxf(nrm, 1e-12f);
        const float kp = xk * (1.0f + (a - 1.0f) * pka[c]);
        const float beta = kk * a;
        const float c1 = wave_sum(beta * xr), c2 = wave_sum(kp * xr), bs = wave_sum(xr * kp * prk[c]);
        float* rp = rec + ((size_t)bh * SEQ + s) * RECF;
        rp[F.lane] = -kk; rp[64 + F.lane] = beta; rp[128 + F.lane] = d; rp[192 + F.lane] = kp; rp[256 + F.lane] = d * xr; rp[320 + F.lane] = xv;
        if (F.lane < 4) rp[384 + F.lane] = F.lane == 0 ? c1 : (F.lane == 1 ? c2 : 0.f);
        gv[(size_t)t * 512 + c] = g;
        if (F.lane == 0) bon[t * 8 + h] = bs;
    }
}

template <int CTRL> __device__ __forceinline__ float dpp_f(float x) { return __builtin_bit_cast(float, __builtin_amdgcn_update_dpp(0, __builtin_bit_cast(int, x), CTRL, 0xF, 0xF, true)); }
__device__ __forceinline__ float allreduce16(float x) { x += dpp_f<0x128>(x); x += dpp_f<0x124>(x); x += dpp_f<0x122>(x); x += dpp_f<0x121>(x); return x; }
__device__ __forceinline__ void phase_rwkv_scan(const Ctx& F) {
    if (F.blk >= 128) return;
    constexpr int TB = 16, CHF = TB * RECF, CH4 = CHF / 4;
    LAS float* buf = (LAS float*)F.lds;
    LAS float* ybuf = (LAS float*)(F.lds + 2 * CHF * 4);
    const int bh = F.blk >> 1, half = F.blk & 1, b = bh >> 3, h = bh & 7;
    const int r = F.lane >> 4, g = F.lane & 15, rowl = F.wave * 4 + r;
    const float* recbase = wsp<float>(F, WS_REC) + (size_t)bh * SEQ * RECF;
    float* yout = wsp<float>(F, WS_YR);
    for (int i = F.tid; i < CH4; i += NTHREADS) ((LAS f32x4*)buf)[i] = ((const f32x4*)recbase)[i];
    __syncthreads();
    f32x4 S = (f32x4){0.f, 0.f, 0.f, 0.f};
    for (int ci = 0; ci < SEQ / TB; ++ci) {
        f32x4 pre[4];
        if (ci + 1 < SEQ / TB) {
#pragma unroll
            for (int q = 0; q < 4; ++q) { const int idx = F.tid + q * NTHREADS; if (idx < CH4) pre[q] = ((const f32x4*)(recbase + (size_t)(ci + 1) * CHF))[idx]; }
        }
        const LAS float* cur = buf + (ci & 1) * CHF; LAS float* yb = ybuf + (ci & 1) * (TB * 32);
#pragma unroll 4
        for (int st = 0; st < TB; ++st) {
            const LAS float* rp = cur + st * RECF;
            const f32x4 nk = *(const LAS f32x4*)(rp + 4 * g), be = *(const LAS f32x4*)(rp + 64 + 4 * g), dd = *(const LAS f32x4*)(rp + 128 + 4 * g);
            const f32x4 kp = *(const LAS f32x4*)(rp + 192 + 4 * g), dr = *(const LAS f32x4*)(rp + 256 + 4 * g);
            const float vv = rp[320 + half * 32 + rowl], c1 = rp[384], c2 = rp[385];
            float sa = (S[0] * nk[0] + S[1] * nk[1]) + (S[2] * nk[2] + S[3] * nk[3]);
            float p = (S[0] * dr[0] + S[1] * dr[1]) + (S[2] * dr[2] + S[3] * dr[3]);
            sa = allreduce16(sa); p = allreduce16(p);
            S = S * dd + (be * sa + kp * vv);
            const float y = p + sa * c1 + vv * c2;
            if (g == 0) yb[st * 32 + rowl] = y;
        }
        if (ci + 1 < SEQ / TB) {
#pragma unroll
            for (int q = 0; q < 4; ++q) { const int idx = F.tid + q * NTHREADS; if (idx < CH4) ((LAS f32x4*)(buf + ((ci + 1) & 1) * CHF))[idx] = pre[q]; }
        }
        __syncthreads();
        { const int st = F.tid >> 5, rr = F.tid & 31; yout[((size_t)b * SEQ + ci * TB + st) * 512 + h * 64 + half * 32 + rr] = yb[F.tid]; }
    }
}
__device__ __forceinline__ void phase_rwkv_post(const Ctx& F, int l) {
    const float* yr = wsp<float>(F, WS_YR); const float* rec = wsp<float>(F, WS_REC); const float* gv = wsp<float>(F, WS_GV); const float* bon = wsp<float>(F, SM_BON);
    const float* gng = F.in[19] + l * 512; const float* gnb = F.in[20] + l * 512; bf16_t* mixed = wsp<bf16_t>(F, WS_MIXED);
    for (int item = F.gw; item < T_TOK * 8; item += F.ngw) {
        const int t = item >> 3, h = item & 7, c = h * 64 + F.lane, s = t & (SEQ - 1), bh = (t >> 11) * 8 + h;
        const float y = yr[(size_t)t * 512 + c];
        const float mean = wave_sum(y) * (1.0f / 64.0f); const float dv = y - mean;
        const float var = wave_sum(dv * dv) * (1.0f / 64.0f);
        const float yn = dv * (1.0f / sqrtf(var + 64e-5f)) * gng[c] + gnb[c];
        const float v = rec[((size_t)bh * SEQ + s) * RECF + 320 + F.lane];
        const float o = (yn + bon[t * 8 + h] * v) * gv[(size_t)t * 512 + c];
        mixed[(size_t)t * DM + 512 + c] = (bf16_t)f2bf(o);
    }
}

__device__ __forceinline__ void conv8(const bf16_t* proj, int t, int sabs, int col, const float* cw, const float* cb, float (&o)[2][8]) {
    float x[5][8];
#pragma unroll
    for (int i = 0; i < 5; ++i) { const int sa = sabs - 3 + i; u32x4 w = (u32x4){0u, 0u, 0u, 0u}; if (sa >= 0) w = *(const u32x4*)(proj + (size_t)(t - 3 + i) * NPROJ + col);
#pragma unroll
        for (int j = 0; j < 4; ++j) { x[i][2 * j] = bflo(w[j]); x[i][2 * j + 1] = bfhi(w[j]); } }
#pragma unroll
    for (int e = 0; e < 8; ++e) { const float w0 = cw[0 * 1024 + col + e], w1 = cw[1 * 1024 + col + e], w2 = cw[2 * 1024 + col + e], w3 = cw[3 * 1024 + col + e], bb = cb[col + e];
#pragma unroll
        for (int rr = 0; rr < 2; ++rr) { const float a = x[rr][e] * w0 + x[rr + 1][e] * w1 + x[rr + 2][e] * w2 + x[rr + 3][e] * w3 + bb; o[rr][e] = a * sigmoidf_(a); } }
}
__device__ __forceinline__ void phase_mlstm_prep(const Ctx& F, int l) {
    const bf16_t* proj = wsp<bf16_t>(F, WS_PROJ); const float* gates = wsp<float>(F, SM_GATES);
    bf16_t* qc = wsp<bf16_t>(F, WS_QC); bf16_t* kc = wsp<bf16_t>(F, WS_KC);
    float* bcum = wsp<float>(F, SM_BCUM); float* iga = wsp<float>(F, SM_IGA); float* mloc = wsp<float>(F, SM_MLOC); float* blast = wsp<float>(F, SM_BLAST);
    float* cloc = wsp<float>(F, WS_CLOC); float* nloc = wsp<float>(F, SM_NLOC);
    const float* cw = F.in[5] + (size_t)l * 4 * 1024; const float* cb = F.in[6] + (size_t)l * 1024; const float* igb = F.in[7] + l * 4; const float* fgb = F.in[8] + l * 4;
    LAS bf16_t* KT = (LAS bf16_t*)F.lds;
    LAS bf16_t* VT = (LAS bf16_t*)(F.lds + 18432);
    LAS float* wsrc = (LAS float*)(F.lds + 36864);
    for (int u = F.blk; u < 1024; u += F.G) {
        const int bh = u >> 5, c = u & 31, b = bh >> 2, h = bh & 3, t0 = b * SEQ + c * 64;
        if (F.wave == 0) {
            const int t = t0 + F.lane;
            const float ig = gates[(size_t)t * 8 + h] + igb[h]; const float f = gates[(size_t)t * 8 + 4 + h] + fgb[h];
            float x = -softplusf_(-f);
#pragma unroll
            for (int o = 1; o < 64; o <<= 1) { const float y = __shfl_up(x, o); if (F.lane >= o) x += y; }
            const float bl = __shfl(x, 63); const float src = bl - x + ig; const float ml = wave_max(src);
            wsrc[F.lane] = __expf(src - ml); bcum[(size_t)t * 4 + h] = x; iga[(size_t)t * 4 + h] = ig;
            if (F.lane == 0) { mloc[u] = ml; blast[u] = bl; }
        }
        __syncthreads();
        {
            const int jj = (F.tid & 15) * 8, s0 = (F.tid >> 4) * 2, t = t0 + s0, sabs = c * 64 + s0;
            float o[2][8];
            conv8(proj, t, sabs, h * 128 + jj, cw, cb, o);
#pragma unroll
            for (int rr = 0; rr < 2; ++rr) { u32x4 w; w.x = pk2(o[rr][0], o[rr][1]); w.y = pk2(o[rr][2], o[rr][3]); w.z = pk2(o[rr][4], o[rr][5]); w.w = pk2(o[rr][6], o[rr][7]);
                *(u32x4*)(qc + (size_t)(t + rr) * 512 + h * 128 + jj) = w; }
            conv8(proj, t, sabs, 512 + h * 128 + jj, cw, cb, o);
#pragma unroll
            for (int rr = 0; rr < 2; ++rr) { unsigned kb[8];
#pragma unroll
                for (int e = 0; e < 8; ++e) { kb[e] = f2bf(o[rr][e] * 0.08838834764831845f); KT[(jj + e) * 72 + s0 + rr] = (bf16_t)kb[e]; }
                u32x4 w; w.x = kb[0] | (kb[1] << 16); w.y = kb[2] | (kb[3] << 16); w.z = kb[4] | (kb[5] << 16); w.w = kb[6] | (kb[7] << 16);
                *(u32x4*)(kc + (size_t)(t + rr) * 512 + h * 128 + jj) = w; }
#pragma unroll
            for (int rr = 0; rr < 2; ++rr) { const u32x4 w = *(const u32x4*)(proj + (size_t)(t + rr) * NPROJ + 1024 + h * 128 + jj); const float ws = wsrc[s0 + rr];
#pragma unroll
                for (int j = 0; j < 4; ++j) { VT[(jj + 2 * j) * 72 + s0 + rr] = (bf16_t)f2bf(bflo(w[j]) * ws); VT[(jj + 2 * j + 1) * 72 + s0 + rr] = (bf16_t)f2bf(bfhi(w[j]) * ws); } }
        }
        __syncthreads();
        {
            const int fr = F.lane & 15, fq = F.lane >> 4;
            bf16x8 a[2];
#pragma unroll
            for (int ks = 0; ks < 2; ++ks) a[ks] = *(const LAS bf16x8*)(VT + (16 * F.wave + fr) * 72 + 32 * ks + 8 * fq);
            float* cbase = cloc + (size_t)u * 16384;
#pragma unroll
            for (int nt = 0; nt < 8; ++nt) {
                f32x4 acc = (f32x4){0.f, 0.f, 0.f, 0.f};
#pragma unroll
                for (int ks = 0; ks < 2; ++ks) { const bf16x8 bb = *(const LAS bf16x8*)(KT + (16 * nt + fr) * 72 + 32 * ks + 8 * fq); acc = __builtin_amdgcn_mfma_f32_16x16x32_bf16(a[ks], bb, acc, 0, 0, 0); }
#pragma unroll
                for (int rg = 0; rg < 4; ++rg) cbase[(16 * F.wave + 4 * fq + rg) * 128 + 16 * nt + fr] = acc[rg];
            }
            if (F.tid < 128) { float s = 0.f;
#pragma unroll 8
                for (int ss = 0; ss < 64; ++ss) s += wsrc[ss] * bf2f(KT[F.tid * 72 + ss]);
                nloc[(size_t)u * 128 + F.tid] = s; }
        }
        __syncthreads();
    }
}
__device__ __forceinline__ void phase_mlstm_scan(const Ctx& F) {
    const float* mloc = wsp<float>(F, SM_MLOC); const float* blast = wsp<float>(F, SM_BLAST); float* mprev = wsp<float>(F, SM_MPREV);
    const float* cloc = wsp<float>(F, WS_CLOC); const float* nloc = wsp<float>(F, SM_NLOC); bf16_t* cprev = wsp<bf16_t>(F, WS_CPREV);
    const int gt = F.blk * NTHREADS + F.tid, ngt = F.G * NTHREADS;
    for (int i = gt; i < 32 * 4096; i += ngt) {
        const int bh = i >> 12, q = i & 4095, e4 = q * 4;
        f32x4 C = (f32x4){0.f, 0.f, 0.f, 0.f}, nn = (f32x4){0.f, 0.f, 0.f, 0.f}; float m = 0.f;
        for (int c = 0; c < 32; ++c) {
            const int u = bh * 32 + c; bf16_t* cp = cprev + (size_t)u * 144 * 128;
            { u32x2 w; w.x = pk2(C[0], C[1]); w.y = pk2(C[2], C[3]); *(u32x2*)(cp + e4) = w; }
            if (q < 32) { u32x2 w; w.x = pk2(nn[0], nn[1]); w.y = pk2(nn[2], nn[3]); *(u32x2*)(cp + 128 * 128 + 4 * q) = w; }
            else if (q < 32 + 240) { *(u32x4*)(cp + 129 * 128 + (q - 32) * 8) = (u32x4){0u, 0u, 0u, 0u}; }
            if (q == 0) mprev[u] = m;
            const float bl = blast[u], ml = mloc[u];
            const float mn = fmaxf(bl + m, ml), a = __expf(bl + m - mn), cc = __expf(ml - mn);
            C = C * a + *(const f32x4*)(cloc + (size_t)u * 16384 + e4) * cc;
            if (q < 32) nn = nn * a + *(const f32x4*)(nloc + (size_t)u * 128 + 4 * q) * cc;
            m = mn;
        }
    }
}
__device__ __forceinline__ void phase_mlstm_out(const Ctx& F, int l, int first, int stride) {
    const bf16_t* proj = wsp<bf16_t>(F, WS_PROJ); const bf16_t* qc = wsp<bf16_t>(F, WS_QC); const bf16_t* kc = wsp<bf16_t>(F, WS_KC);
    const float* bcum = wsp<float>(F, SM_BCUM); const float* iga = wsp<float>(F, SM_IGA); const float* mprev = wsp<float>(F, SM_MPREV);
    const bf16_t* cprev = wsp<bf16_t>(F, WS_CPREV); bf16_t* mixed = wsp<bf16_t>(F, WS_MIXED); const float* ng = F.in[9] + l * 512;
    LAS bf16_t* VT = (LAS bf16_t*)F.lds;
    LAS bf16_t* PM = (LAS bf16_t*)(F.lds + 20736);
    LAS float* sc = (LAS float*)(F.lds + 20736 + 9216);
    const int fr = F.lane & 15, fq = F.lane >> 4;
    for (int u = first; u < 1024; u += stride) {
        const int bh = u >> 5, c = u & 31, b = bh >> 2, h = bh & 3, t0 = b * SEQ + c * 64;
        if (F.wave == 0) {
            const int t = t0 + F.lane; const float bb = bcum[(size_t)t * 4 + h], ig = iga[(size_t)t * 4 + h], mp = mprev[u];
            const float gqv = ig - bb; float pm = gqv;
#pragma unroll
            for (int o = 1; o < 64; o <<= 1) { const float y = __shfl_up(pm, o); if (F.lane >= o) pm = fmaxf(pm, y); }
            const float mt = bb + fmaxf(mp, pm);
            sc[F.lane] = bb - mt; sc[64 + F.lane] = gqv; sc[128 + F.lane] = __expf(bb + mp - mt); sc[192 + F.lane] = __expf(-mt);
        }
        {
            const int jj = (F.tid & 15) * 8, s0 = (F.tid >> 4) * 2;
#pragma unroll
            for (int rr = 0; rr < 2; ++rr) { const u32x4 w = *(const u32x4*)(proj + (size_t)(t0 + s0 + rr) * NPROJ + 1024 + h * 128 + jj);
#pragma unroll
                for (int j = 0; j < 4; ++j) { VT[(jj + 2 * j) * 72 + s0 + rr] = (bf16_t)(w[j] & 0xffffu); VT[(jj + 2 * j + 1) * 72 + s0 + rr] = (bf16_t)(w[j] >> 16); } }
            for (int i = F.tid; i < 16 * 64; i += NTHREADS) { const int rrow = i >> 6, cc = i & 63; VT[(128 + rrow) * 72 + cc] = rrow == 0 ? (bf16_t)0x3F80 : (bf16_t)0; }
        }
        __syncthreads();
        const int tt = F.wave & 3, hf = F.wave >> 2;
        bf16x8 qa[4];
#pragma unroll
        for (int ks = 0; ks < 4; ++ks) qa[ks] = *(const bf16x8*)(qc + (size_t)(t0 + 16 * tt + fr) * 512 + h * 128 + 32 * ks + 8 * fq);
        {
            const int trow = 16 * tt + fr; const float re = sc[trow];
#pragma unroll
            for (int si = 0; si < 2; ++si) { const int st = 2 * hf + si; f32x4 acc = (f32x4){0.f, 0.f, 0.f, 0.f};
#pragma unroll
                for (int ks = 0; ks < 4; ++ks) { const bf16x8 kb = *(const bf16x8*)(kc + (size_t)(t0 + 16 * st + fr) * 512 + h * 128 + 32 * ks + 8 * fq);
                    acc = __builtin_amdgcn_mfma_f32_16x16x32_bf16(kb, qa[ks], acc, 0, 0, 0); }
                float pv[4];
#pragma unroll
                for (int j = 0; j < 4; ++j) { const int s = 16 * st + 4 * fq + j; const float e = __expf(re + sc[64 + s]); pv[j] = (s <= trow) ? acc[j] * e : 0.f; }
                u32x2 w; w.x = pk2(pv[0], pv[1]); w.y = pk2(pv[2], pv[3]); *(LAS u32x2*)(PM + trow * 72 + 16 * st + 4 * fq) = w; }
        }
        __syncthreads();
        {
            const int trow = 16 * tt + fr, t = t0 + trow; const float wi = sc[128 + trow], enm = sc[192 + trow];
            bf16x8 pa[2];
#pragma unroll
            for (int ks = 0; ks < 2; ++ks) pa[ks] = *(const LAS bf16x8*)(PM + trow * 72 + 32 * ks + 8 * fq);
            const bf16_t* cp = cprev + (size_t)u * 144 * 128;
            f32x4 num[5];
#pragma unroll
            for (int ci = 0; ci < 5; ++ci) { const int ct = ci < 4 ? 4 * hf + ci : 8;
                f32x4 apv = (f32x4){0.f, 0.f, 0.f, 0.f}, ain = (f32x4){0.f, 0.f, 0.f, 0.f};
#pragma unroll
                for (int ks = 0; ks < 2; ++ks) { const bf16x8 vb = *(const LAS bf16x8*)(VT + (16 * ct + fr) * 72 + 32 * ks + 8 * fq); apv = __builtin_amdgcn_mfma_f32_16x16x32_bf16(vb, pa[ks], apv, 0, 0, 0); }
#pragma unroll
                for (int ks = 0; ks < 4; ++ks) { const bf16x8 cb = *(const bf16x8*)(cp + (size_t)(16 * ct + fr) * 128 + 32 * ks + 8 * fq); ain = __builtin_amdgcn_mfma_f32_16x16x32_bf16(cb, qa[ks], ain, 0, 0, 0); }
                num[ci] = apv + ain * wi; }
            const float den = __shfl(num[4][0], fr);
            const float dn = 1.0f / fmaxf(fabsf(den), enm);
            float s1 = 0.f;
#pragma unroll
            for (int ci = 0; ci < 4; ++ci) { num[ci] = num[ci] * dn; s1 += (num[ci][0] + num[ci][1]) + (num[ci][2] + num[ci][3]); }
            s1 += __shfl_xor(s1, 16); s1 += __shfl_xor(s1, 32);
            if (fq == 0) sc[256 + trow * 2 + hf] = s1;
            __syncthreads();
            const float mean = (sc[256 + trow * 2] + sc[256 + trow * 2 + 1]) * (1.0f / 128.0f);
            float s2 = 0.f;
#pragma unroll
            for (int ci = 0; ci < 4; ++ci) { num[ci] = num[ci] - mean; s2 += (num[ci][0] * num[ci][0] + num[ci][1] * num[ci][1]) + (num[ci][2] * num[ci][2] + num[ci][3] * num[ci][3]); }
            s2 += __shfl_xor(s2, 16); s2 += __shfl_xor(s2, 32);
            if (fq == 0) sc[384 + trow * 2 + hf] = s2;
            __syncthreads();
            const float rstd = 1.0f / sqrtf((sc[384 + trow * 2] + sc[384 + trow * 2 + 1]) * (1.0f / 128.0f) + 1e-5f);
#pragma unroll
            for (int ci = 0; ci < 4; ++ci) { const int col = h * 128 + 16 * (4 * hf + ci) + 4 * fq;
                const u32x2 mo = *(const u32x2*)(proj + (size_t)t * NPROJ + 1536 + col); const f32x4 gg = *(const f32x4*)(ng + col);
                const float o0 = num[ci][0] * rstd * gg[0] * sigmoidf_(bflo(mo.x)), o1 = num[ci][1] * rstd * gg[1] * sigmoidf_(bfhi(mo.x));
                const float o2 = num[ci][2] * rstd * gg[2] * sigmoidf_(bflo(mo.y)), o3 = num[ci][3] * rstd * gg[3] * sigmoidf_(bfhi(mo.y));
                u32x2 w; w.x = pk2(o0, o1); w.y = pk2(o2, o3); *(u32x2*)(mixed + (size_t)t * DM + col) = w; }
        }
        __syncthreads();
    }
}

__device__ __forceinline__ void phase_router(const Ctx& F, int l) {
    LAS float* W = (LAS float*)F.lds;
    LAS float* lg = (LAS float*)(F.lds + MISC_OFF);
    LAS unsigned* hist = (LAS unsigned*)(F.lds + MISC_OFF + 2048);
    const float* wr = F.in[29] + (size_t)l * 1024 * 32; const float* br = F.in[30] + l * 32;
    const float* H = wsp<float>(F, WS_H); int* topi = wsp<int>(F, SM_TOPI); float* topg = wsp<float>(F, SM_TOPG); unsigned* ctl = wsp<unsigned>(F, WS_CTL);
    for (int i = F.tid; i < 8192; i += NTHREADS) ((LAS f32x4*)W)[i] = ((const f32x4*)wr)[i];
    if (F.tid < 32) hist[F.tid] = 0u;
    __syncthreads();
    const int r = F.tid >> 5, e = F.tid & 31;
    for (int base = F.blk * 16; base < T_TOK; base += F.G * 16) {
        const int t = base + r; const float* hr = H + (size_t)t * DM;
        float a0 = br[e], a1 = 0.f, a2 = 0.f, a3 = 0.f;
#pragma unroll 4
        for (int d4 = 0; d4 < 256; ++d4) { const f32x4 hv = *(const f32x4*)(hr + 4 * d4); const LAS float* wp = W + (4 * d4) * 32 + e;
            a0 += hv[0] * wp[0]; a1 += hv[1] * wp[32]; a2 += hv[2] * wp[64]; a3 += hv[3] * wp[96]; }
        lg[r * 32 + e] = (a0 + a1) + (a2 + a3);
        __syncthreads();
        if (e == 0) {
            float v[4]; int id[4]; unsigned used = 0u;
#pragma unroll
            for (int k = 0; k < 4; ++k) { float best = -3.0e38f; int bi = 0;
                for (int j = 0; j < 32; ++j) { const float x = lg[r * 32 + j]; if (!((used >> j) & 1u) && x > best) { best = x; bi = j; } }
                used |= 1u << bi; v[k] = best; id[k] = bi; }
            const float e1 = __expf(v[1] - v[0]), e2 = __expf(v[2] - v[0]), e3 = __expf(v[3] - v[0]); const float inv = 1.0f / (1.0f + e1 + e2 + e3);
            topi[t * 4 + 0] = id[0]; topi[t * 4 + 1] = id[1]; topi[t * 4 + 2] = id[2]; topi[t * 4 + 3] = id[3];
            topg[t * 4 + 0] = inv; topg[t * 4 + 1] = e1 * inv; topg[t * 4 + 2] = e2 * inv; topg[t * 4 + 3] = e3 * inv;
#pragma unroll
            for (int k = 0; k < 4; ++k) atomicAdd((unsigned*)&hist[id[k]], 1u);
        }
        __syncthreads();
    }
    if (F.tid < 32 && hist[F.tid]) atomicAdd(&ctl[CW_CNT + l * 32 + F.tid], hist[F.tid]);
}
__device__ __forceinline__ void phase_slots(const Ctx& F, int l) {
    LAS unsigned* lc = (LAS unsigned*)F.lds; LAS unsigned* lbase = lc + 32; LAS unsigned* pst = lc + 64; LAS int* aslot = (LAS int*)(lc + 128); LAS int* atok = aslot + 256;
    unsigned* ctl = wsp<unsigned>(F, WS_CTL); const int* topi = wsp<int>(F, SM_TOPI); int* slotp = wsp<int>(F, SM_SLOT);
    const bf16_t* HB = wsp<bf16_t>(F, WS_HB); bf16_t* XG = wsp<bf16_t>(F, WS_XG);
    if (F.tid < 32) lc[F.tid] = 0u;
    if (F.tid == 0) { unsigned acc = 0u;
        for (int e = 0; e < 32; ++e) { pst[e] = acc; const unsigned c = ctl[CW_CNT + l * 32 + e]; acc += ((c + 255u) >> 8) << 8; }
        pst[32] = acc;
        if (F.blk == 0) for (int e = 0; e <= 32; ++e) ctl[CW_TILE + l * 40 + e] = pst[e] >> 8; }
    __syncthreads();
    for (int tb = F.blk; tb < T_TOK / 64; tb += F.G) {
        int myE = 0, myRank = 0, t = 0, k = 0;
        if (F.tid < 256) { t = tb * 64 + (F.tid >> 2); k = F.tid & 3; myE = topi[t * 4 + k]; myRank = (int)atomicAdd((unsigned*)&lc[myE], 1u); }
        __syncthreads();
        if (F.tid < 32) lbase[F.tid] = lc[F.tid] ? atomicAdd(&ctl[CW_CUR + l * 32 + F.tid], lc[F.tid]) : 0u;
        __syncthreads();
        if (F.tid < 256) { const int sl = (int)(pst[myE] + lbase[myE]) + myRank; slotp[t * 4 + k] = sl; aslot[F.tid] = sl; atok[F.tid] = t; }
        __syncthreads();
        if (F.tid < 32) lc[F.tid] = 0u;
        for (int a = 0; a < 32; ++a) { const int idx = F.wave * 32 + a; const int sl = aslot[idx], tk = atok[idx];
            const u32x4* src = (const u32x4*)(HB + (size_t)tk * DM); u32x4* dst = (u32x4*)(XG + (size_t)sl * DM);
            dst[F.lane] = src[F.lane]; dst[64 + F.lane] = src[64 + F.lane]; }
        __syncthreads();
    }
}

__device__ __forceinline__ const void* launder(const void* p) {
    unsigned long long x = (unsigned long long)p; unsigned lo = (unsigned)x, hi = (unsigned)(x >> 32);
    asm volatile("" : "+v"(lo), "+v"(hi));
    lo = __builtin_amdgcn_readfirstlane(lo); hi = __builtin_amdgcn_readfirstlane(hi);
    return (const void*)(((unsigned long long)hi << 32) | lo);
}
__device__ __forceinline__ void moe_build_units(const Ctx& F, int l, int npn) {
    LAS int* ul = (LAS int*)(F.lds + MISC_OFF + 4096);
    const unsigned* ts = wsp<unsigned>(F, WS_CTL) + CW_TILE + l * 40;
    if (F.tid < 16) {
        const int NT = (int)ts[32]; const long L = (long)F.tid * F.G + F.blk; int pm = -1, pn = 0, e = 0;
        if (L < (long)NT * npn) { pm = (int)(L / npn); pn = (int)(L % npn); for (int j = 1; j < 32; ++j) e += ((int)ts[j] <= pm) ? 1 : 0; }
        ul[3 * F.tid] = pm; ul[3 * F.tid + 1] = pn; ul[3 * F.tid + 2] = e;
    }
    __syncthreads();
}

#define XB_TMO      128
#define XB_XCNT(j)  (256  + 64 * (j))
#define XB_XSUB(j)  (1280 + 64 * (j))
#define XB_XGEN(j)  (2304 + 64 * (j))
#define XB_TOP      3328
#define XB_TOPGEN   3392
#define XCD_BAR_WORDS 3456
#define XB_SPIN_CAP (1u << 22)
constexpr int CW_BAR = 1024;
__device__ __forceinline__ unsigned xb_ld(unsigned* p)              { return __hip_atomic_load(p, __ATOMIC_RELAXED, __HIP_MEMORY_SCOPE_AGENT); }
__device__ __forceinline__ unsigned xb_add(unsigned* p, unsigned v) { return __hip_atomic_fetch_add(p, v, __ATOMIC_RELAXED, __HIP_MEMORY_SCOPE_AGENT); }
__device__ __forceinline__ unsigned xb_xcc_id() { return (unsigned)__builtin_amdgcn_s_getreg((3 << 11) | 20) & 0xFu; }
#define XB_SPIN(cond, bar) do { unsigned _sp = 0; while (cond) { __builtin_amdgcn_s_sleep(1); \
    if ((++_sp & 255u) == 0u) { if (xb_ld(&(bar)[XB_TMO])) break; if (_sp > XB_SPIN_CAP) { atomicAdd(&(bar)[XB_TMO], 1u); break; } } } } while (0)
struct XcdBarrier { unsigned* bar; unsigned x; volatile LAS unsigned* st; };
__device__ __forceinline__ XcdBarrier xcd_barrier_post(unsigned* bar, volatile LAS unsigned* st) {
    XcdBarrier b; b.bar = bar; b.x = xb_xcc_id(); b.st = st;
    if (threadIdx.x == 0) (void)xb_add(&bar[XB_XCNT(b.x)], 1u);
    return b;
}
__device__ __forceinline__ void xcd_barrier_complete(unsigned* bar, unsigned x, unsigned& nloc, unsigned& nx) {
    const unsigned G = gridDim.x * gridDim.y * gridDim.z;
    unsigned sum, cnt, mine, sp = 0u;
    for (;;) {
        sum = 0u; cnt = 0u; mine = 0u;
#pragma unroll
        for (unsigned j = 0; j < 16; ++j) { const unsigned c = xb_ld(&bar[XB_XCNT(j)]); sum += c; cnt += (c > 0u) ? 1u : 0u; mine = (j == x) ? c : mine; }
        if (sum == G) break;
        __builtin_amdgcn_s_sleep(1);
        if ((++sp & 255u) == 0u) { if (xb_ld(&bar[XB_TMO])) break; if (sp > XB_SPIN_CAP) { atomicAdd(&bar[XB_TMO], 1u); break; } }
    }
    nloc = mine > 0u ? mine : 1u; nx = cnt > 0u ? cnt : 1u;
}
__device__ __forceinline__ void xcd_barrier(const XcdBarrier& b) {
    asm volatile("s_waitcnt vmcnt(0)" ::: "memory");
    __syncthreads();
    if (threadIdx.x == 0) {
        unsigned* bar = b.bar;
        __builtin_amdgcn_s_waitcnt(0);
        unsigned nloc = b.st[0], nx = b.st[1];
        if (nloc == 0u) { xcd_barrier_complete(bar, b.x, nloc, nx); b.st[0] = nloc; b.st[1] = nx; }
        const unsigned old = xb_add(&bar[XB_XSUB(b.x)], 1u);
        const unsigned gen = old / nloc;
        if (old + 1u == (gen + 1u) * nloc) {
            __builtin_amdgcn_fence(__ATOMIC_RELEASE, "agent");
            asm volatile("s_waitcnt vmcnt(0)" ::: "memory");
            const unsigned og = xb_add(&bar[XB_TOP], 1u);
            const unsigned tg = og / nx;
            if (og + 1u == (tg + 1u) * nx) xb_add(&bar[XB_TOPGEN], 1u);
            else XB_SPIN(xb_ld(&bar[XB_TOPGEN]) == tg, bar);
            __builtin_amdgcn_fence(__ATOMIC_ACQUIRE, "agent");
            xb_add(&bar[XB_XGEN(b.x)], 1u);
            asm volatile("s_waitcnt vmcnt(0)" ::: "memory");
        } else {
            XB_SPIN(xb_ld(&bar[XB_XGEN(b.x)]) == gen, bar);
            __builtin_amdgcn_fence(__ATOMIC_ACQUIRE, "agent");
            asm volatile("s_waitcnt vmcnt(0)" ::: "memory");
        }
    }
    __syncthreads();
}
constexpr int PH_PER_LAYER = 18, NPHASES = 2 + DEPTH * PH_PER_LAYER;
__global__ void __launch_bounds__(NTHREADS, 2) mk_fwd(Args args) {
    extern __shared__ __attribute__((aligned(16))) unsigned char lds_raw[];
    Ctx F; F.lds = (LAS unsigned char*)lds_raw; F.tid = threadIdx.x; F.lane = F.tid & 63; F.wave = __builtin_amdgcn_readfirstlane(F.tid >> 6);
    F.blk = blockIdx.x; F.G = gridDim.x; F.gw = F.blk * NWAVES + F.wave; F.ngw = F.G * NWAVES;
    {   LAS unsigned long long* tab = (LAS unsigned long long*)(F.lds + TAB_OFF);
        if (F.tid == 0) {
#define TB_(k) tab[k] = (unsigned long long)args.in[k];
            TB_(0) TB_(1) TB_(2) TB_(3) TB_(4) TB_(5) TB_(6) TB_(7) TB_(8) TB_(9) TB_(10) TB_(11) TB_(12) TB_(13) TB_(14) TB_(15) TB_(16) TB_(17) TB_(18)
            TB_(19) TB_(20) TB_(21) TB_(22) TB_(23) TB_(24) TB_(25) TB_(26) TB_(27) TB_(28) TB_(29) TB_(30) TB_(31) TB_(32) TB_(33) TB_(34) TB_(35) TB_(36)
#undef TB_
            tab[37] = (unsigned long long)args.out; tab[38] = (unsigned long long)args.ws;
            ((LAS unsigned*)(F.lds + TAB_OFF + 512))[0] = 0u; ((LAS unsigned*)(F.lds + TAB_OFF + 512))[1] = 0u; }
        __syncthreads();
        F.in.t = (LAS const volatile unsigned*)(F.lds + TAB_OFF); F.out = nullptr; F.ws = nullptr; }
    const int lo = args.ph_lo, hi = args.ph_hi;
    XcdBarrier xbar = xcd_barrier_post((unsigned*)(args.ws + WS_CTL) + CW_BAR, (volatile LAS unsigned*)(F.lds + TAB_OFF + 512));
#if ONE_LAUNCH
    cg::grid_group grid = cg::this_grid();
#define SEAM(k) do { if ((k) + 1 < hi) { if ((k) == 0) grid.sync(); else xcd_barrier(xbar); } } while (0)
#else
#define SEAM(k) do { } while (0)
#endif
#ifndef PHMASK
#define PHMASK 0xFFFFFu
#endif
#define IN(k) (lo <= (k) && (k) < hi)
#define ON(r) (((PHMASK) >> (r)) & 1u)
#define FRESH() do { int _t = threadIdx.x; int _b = blockIdx.x, _g = gridDim.x; unsigned _l = (unsigned)(uintptr_t)(LAS unsigned char*)lds_raw; asm volatile("" : "+v"(_t), "+s"(_b), "+s"(_g), "+s"(_l)); F.tid = _t; F.lane = _t & 63; F.wave = __builtin_amdgcn_readfirstlane(_t >> 6); F.blk = _b; F.G = _g; F.gw = _b * NWAVES + F.wave; F.ngw = _g * NWAVES; F.lds = (LAS unsigned char*)(uintptr_t)_l; lds = F.lds; F.in.t = (LAS const volatile unsigned*)(F.lds + TAB_OFF); F.out = (float*)F.in.get(37); F.ws = (unsigned char*)F.in.get(38); } while (0)
    LAS unsigned char* lds = F.lds;
    if (ON(18) && IN(0)) { FRESH(); phase_prologue(F); __syncthreads(); SEAM(0); }
    if (ON(19) && IN(1)) { FRESH();
        pg8::KvOrder S; S.memb = (const char*)wsp<bf16_t>(F, WS_MEMB); S.wkv = (const char*)wsp<bf16_t>(F, WS_WKV); S.lda = 1024; S.ldb = 1024; S.K = 1024; S.G = F.G; S.c = F.blk;
        pg8::EpiKv E{wsp<bf16_t>(F, WS_KBUF), wsp<bf16_t>(F, WS_VTB)};
        pg8::gemm_phase(lds, S, E); __syncthreads(); SEAM(1);
    }
    for (int l = 0; l < DEPTH; ++l) {
        const int pb = 2 + l * PH_PER_LAYER;
        if (ON(0) && IN(pb + 0)) { FRESH();
            pg8::DenseOrder S; S.init(wsp<bf16_t>(F, WS_HB), wsp<bf16_t>(F, WS_WIN) + (size_t)l * 4096 * 1024, T_TOK, NPROJ, 1024, 1024, 1024, F.G, F.blk);
            pg8::EpiProj E{wsp<bf16_t>(F, WS_PROJ), wsp<float>(F, SM_GATES)};
            pg8::gemm_phase(lds, S, E); __syncthreads(); SEAM(pb + 0);
        }
        if (ON(1) && IN(pb + 1)) { FRESH(); phase_xlr(F, l); phase_mlstm_prep(F, l); __syncthreads(); SEAM(pb + 1); }
        if (ON(2) && IN(pb + 2)) { FRESH();
            pg8::DenseOrder S; S.init(wsp<bf16_t>(F, WS_XLR), wsp<bf16_t>(F, WS_WLR) + (size_t)l * 1536 * 256, T_TOK, 1536, 256, 256, 256, F.G, F.blk);
            pg8::EpiF32 E{wsp<float>(F, WS_LR), 1536};
            pg8::gemm_phase(lds, S, E); __syncthreads();
            phase_mlstm_scan(F); SEAM(pb + 2);
        }
        if (ON(3) && IN(pb + 3)) { FRESH(); phase_rwkv_prep(F, l); SEAM(pb + 3); }
        if (ON(4) && IN(pb + 4)) { FRESH(); if (F.blk < 128) phase_rwkv_scan(F); else phase_mlstm_out(F, l, F.blk - 128, F.G - 128); __syncthreads(); SEAM(pb + 4); }
        if (ON(5) && IN(pb + 5)) { FRESH(); phase_rwkv_post(F, l); SEAM(pb + 5); }
        if (ON(6) && IN(pb + 6)) { FRESH();
            pg8::DenseOrder S; S.init(wsp<bf16_t>(F, WS_MIXED), wsp<bf16_t>(F, WS_WOUT) + (size_t)l * 1024 * 1024, T_TOK, 1024, 1024, 1024, 1024, F.G, F.blk);
            pg8::EpiF32 E{wsp<float>(F, WS_CF), 1024};
            pg8::gemm_phase(lds, S, E); __syncthreads(); SEAM(pb + 6);
        }
        if (ON(7) && IN(pb + 7)) { FRESH(); phase_ln_add(F, F.in[22] + l * 1024, F.in[23] + l * 1024); SEAM(pb + 7); }
        if (ON(8) && IN(pb + 8)) { FRESH();
            pg8::DenseOrder S; S.init(wsp<bf16_t>(F, WS_HB), wsp<bf16_t>(F, WS_WQ) + (size_t)l * 1024 * 1024, T_TOK, 1024, 1024, 1024, 1024, F.G, F.blk);
            pg8::EpiBf16 E{wsp<bf16_t>(F, WS_QB), 1024, 0.0625f};
            pg8::gemm_phase(lds, S, E); __syncthreads(); SEAM(pb + 8);
        }
        if (ON(9) && IN(pb + 9)) { FRESH();
            pg8::SOrder S; S.Q = (const char*)wsp<bf16_t>(F, WS_QB); S.Kb = (const char*)(wsp<bf16_t>(F, WS_KBUF) + (size_t)l * 2048 * 1024); S.lda = 1024; S.ldb = 1024; S.K = 256; S.G = F.G; S.c = F.blk;
            pg8::EpiSoftmax E{wsp<bf16_t>(F, WS_PB)};
            pg8::gemm_phase(lds, S, E); __syncthreads(); SEAM(pb + 9);
        }
        if (ON(10) && IN(pb + 10)) { FRESH();
            pg8::PvOrder S; S.P = (const char*)wsp<bf16_t>(F, WS_PB); S.Vt = (const char*)(wsp<bf16_t>(F, WS_VTB) + (size_t)l * 1024 * 2048); S.lda = 256; S.ldb = 2048; S.K = 256; S.G = F.G; S.c = F.blk;
            pg8::EpiPv E{wsp<bf16_t>(F, WS_OB)};
            pg8::gemm_phase(lds, S, E); __syncthreads(); SEAM(pb + 10);
        }
        if (ON(11) && IN(pb + 11)) { FRESH();
            pg8::DenseOrder S; S.init(wsp<bf16_t>(F, WS_OB), wsp<bf16_t>(F, WS_WO) + (size_t)l * 1024 * 1024, T_TOK, 1024, 1024, 1024, 1024, F.G, F.blk);
            pg8::EpiF32 E{wsp<float>(F, WS_CF), 1024};
            pg8::gemm_phase(lds, S, E); __syncthreads(); SEAM(pb + 11);
        }
        if (ON(12) && IN(pb + 12)) { FRESH(); phase_ln_add(F, F.in[27] + l * 1024, F.in[28] + l * 1024); SEAM(pb + 12); }
        if (ON(13) && IN(pb + 13)) { FRESH(); phase_router(F, l); __syncthreads(); SEAM(pb + 13); }
        if (ON(14) && IN(pb + 14)) { FRESH(); phase_slots(F, l); __syncthreads(); SEAM(pb + 14); }
        if (ON(15) && IN(pb + 15)) { FRESH();
            moe_build_units(F, l, 8);
            pg8::MoeOrder S; S.A = (const char*)wsp<bf16_t>(F, WS_XG); S.W = (const char*)(wsp<bf16_t>(F, WS_W1) + (size_t)l * 32 * 2048 * 1024); S.ul = (LAS const int*)(F.lds + MISC_OFF + 4096);
            S.wstride = (size_t)2048 * 1024 * 2; S.lda = 1024; S.ldb = 1024; S.K = 1024;
            pg8::EpiSwiglu E{wsp<bf16_t>(F, WS_GACT), F.in[32] + (size_t)l * 32 * 2048};
            pg8::gemm_phase(lds, S, E); __syncthreads(); SEAM(pb + 15);
        }
        if (ON(16) && IN(pb + 16)) { FRESH();
            moe_build_units(F, l, 4);
            pg8::MoeOrder S; S.A = (const char*)wsp<bf16_t>(F, WS_GACT); S.W = (const char*)(wsp<bf16_t>(F, WS_W2) + (size_t)l * 32 * 1024 * 1024); S.ul = (LAS const int*)(F.lds + MISC_OFF + 4096);
            S.wstride = (size_t)1024 * 1024 * 2; S.lda = 1024; S.ldb = 1024; S.K = 1024;
            pg8::EpiMoeY E{wsp<bf16_t>(F, WS_YB), F.in[34] + (size_t)l * 32 * 1024};
            pg8::gemm_phase(lds, S, E); __syncthreads(); SEAM(pb + 16);
        }
        if (ON(17) && IN(pb + 17)) { FRESH(); phase_ln_moe(F, F.in[35] + l * 1024, F.in[36] + l * 1024, l == DEPTH - 1); SEAM(pb + 17); }
    }
#undef IN
#undef SEAM
}

extern "C" void kernel_launch(void* const* d_in, const int* in_sizes, int n_in, void* d_out, int out_size, void* d_ws, size_t ws_size, hipStream_t stream) {
    static int grid = 0;
    if (grid == 0) {
        if (n_in != 37 || out_size != T_TOK * DM || ws_size < WS_END) { fprintf(stderr, "kernel_launch: unexpected shapes: n_in %d out %d ws %zu (need %zu)\n", n_in, out_size, ws_size, (size_t)WS_END); grid = -1; return; }
        int dev = 0, cus = 0, per_cu = 0;
        hipGetDevice(&dev); hipDeviceGetAttribute(&cus, hipDeviceAttributeMultiprocessorCount, dev);
        if (hipFuncSetAttribute((const void*)mk_fwd, hipFuncAttributeMaxDynamicSharedMemorySize, LDS_BYTES) != hipSuccess) { fprintf(stderr, "kernel_launch: hipFuncSetAttribute failed\n"); grid = -1; return; }
        if (hipOccupancyMaxActiveBlocksPerMultiprocessor(&per_cu, (const void*)mk_fwd, NTHREADS, LDS_BYTES) != hipSuccess || per_cu < 1) { fprintf(stderr, "kernel_launch: occupancy query says %d blocks per CU\n", per_cu); (void)hipGetLastError(); per_cu = 1; }
        grid = cus;
        if (grid > 256) grid = 256;
    }
    if (grid < 0) return;
    (void)hipMemsetAsync((char*)d_ws + WS_CTL, 0, CTL_BYTES, stream);
    Args a{};
    for (int i = 0; i < 37; ++i) a.in[i] = (const float*)d_in[i];
    a.out = (float*)d_out; a.ws = (unsigned char*)d_ws;
#if ONE_LAUNCH
    a.ph_lo = 0; a.ph_hi = NPHASES;
    void* kargs[] = {&a};
    hipError_t e = hipLaunchCooperativeKernel((const void*)mk_fwd, dim3(grid), dim3(NTHREADS), kargs, LDS_BYTES, stream);
    if (e != hipSuccess) fprintf(stderr, "kernel_launch: cooperative launch failed: %s (grid %d)\n", hipGetErrorString(e), grid);
#else
    for (int ph = 0; ph < NPHASES; ++ph) { a.ph_lo = ph; a.ph_hi = ph + 1; hipLaunchKernelGGL(mk_fwd, dim3(grid), dim3(NTHREADS), LDS_BYTES, stream, a); }
#endif
}
```

```cpp
#include <hip/hip_runtime.h>
#include <hip/hip_cooperative_groups.h>
#include <cstdio>
#include <cstdint>
namespace cg = cooperative_groups;

#ifndef PROBE_PH
#define PROBE_PH -1
#endif
#ifndef PROBE_N
#define PROBE_N 0
#endif
#ifndef ONE_LAUNCH
#define ONE_LAUNCH 1
#endif

#define LAS __attribute__((address_space(3)))
typedef unsigned short bf16_t;
typedef short bf16x8 __attribute__((ext_vector_type(8)));
typedef float f32x4 __attribute__((ext_vector_type(4)));
typedef float f32x2 __attribute__((ext_vector_type(2)));
typedef unsigned u32x4 __attribute__((ext_vector_type(4)));
typedef unsigned u32x2 __attribute__((ext_vector_type(2)));

constexpr int T_TOK = 16384, DM = 1024, SEQ = 2048, NBATCH = 8, DEPTH = 2;
constexpr int IN_COLS = 3848, NPROJ = 4096;
constexpr int RC0 = 2048;
constexpr int NEXP = 32, NMEM = 256;
constexpr int MOE_ROWS = 65536 + NEXP * 256;
constexpr int RECF = 388;
constexpr float DN_ALPHA = 1.4142135623730951f;
constexpr int NTHREADS = 512, NWAVES = 8;
constexpr int LDS_BYTES = 147456;
constexpr int GEMM_LDS = 131072;
constexpr int MISC_OFF = GEMM_LDS;

constexpr size_t MiB = 1u << 20;
constexpr size_t WS_CTL = 0;
constexpr size_t CTL_BYTES = 65536;
constexpr size_t WS_WIN = 1 * MiB;
constexpr size_t WS_WOUT = WS_WIN + 16 * MiB;
constexpr size_t WS_WQ = WS_WOUT + 4 * MiB;
constexpr size_t WS_WKV = WS_WQ + 4 * MiB;
constexpr size_t WS_WO = WS_WKV + 8 * MiB;
constexpr size_t WS_WLR = WS_WO + 4 * MiB;
constexpr size_t WS_W1 = WS_WLR + 2 * MiB;
constexpr size_t WS_W2 = WS_W1 + 256 * MiB;
constexpr size_t WS_H = WS_W2 + 128 * MiB;
constexpr size_t WS_HB = WS_H + 64 * MiB;
constexpr size_t WS_MEMB = WS_HB + 32 * MiB;
constexpr size_t WS_KBUF = WS_MEMB + 4 * MiB;
constexpr size_t WS_VTB = WS_KBUF + 8 * MiB;
constexpr size_t WS_CF = WS_VTB + 8 * MiB;
constexpr size_t WS_MIXED = WS_CF + 64 * MiB;
constexpr size_t WS_QB = WS_MIXED + 32 * MiB;
constexpr size_t WS_PB = WS_QB + 32 * MiB;
constexpr size_t WS_OB = WS_PB + 32 * MiB;
constexpr size_t WS_SMALL = WS_OB + 32 * MiB;
constexpr size_t SM_GATES = WS_SMALL;
constexpr size_t SM_BCUM = SM_GATES + 512 * 1024;
constexpr size_t SM_IGA = SM_BCUM + 256 * 1024;
constexpr size_t SM_BON = SM_IGA + 256 * 1024;
constexpr size_t SM_TOPI = SM_BON + 512 * 1024;
constexpr size_t SM_TOPG = SM_TOPI + 256 * 1024;
constexpr size_t SM_SLOT = SM_TOPG + 256 * 1024;
constexpr size_t SM_MLOC = SM_SLOT + 256 * 1024;
constexpr size_t SM_BLAST = SM_MLOC + 4096;
constexpr size_t SM_MPREV = SM_BLAST + 4096;
constexpr size_t SM_NLOC = SM_MPREV + 4096;
constexpr size_t WS_UNION = WS_SMALL + 8 * MiB;
constexpr size_t WS_PROJ = WS_UNION;
constexpr size_t WS_XLR = WS_PROJ + 128 * MiB;
constexpr size_t WS_LR = WS_XLR + 8 * MiB;
constexpr size_t WS_REC = WS_LR + 96 * MiB;
constexpr size_t WS_GV = WS_REC + 196 * MiB;
constexpr size_t WS_YR = WS_GV + 32 * MiB;
constexpr size_t WS_QC = WS_YR + 32 * MiB;
constexpr size_t WS_KC = WS_QC + 16 * MiB;
constexpr size_t WS_CLOC = WS_KC + 16 * MiB;
constexpr size_t WS_CPREV = WS_CLOC + 64 * MiB;
constexpr size_t WS_MIXEND = WS_CPREV + 36 * MiB;
constexpr size_t WS_XG = WS_UNION;
constexpr size_t WS_GACT = WS_XG + 144 * MiB;
constexpr size_t WS_YB = WS_GACT + 144 * MiB;
constexpr size_t WS_END = WS_MIXEND;
static_assert(WS_YB + 144 * MiB <= WS_MIXEND, "moe overlay fits");
static_assert((size_t)64 * 2048 * RECF * 4 <= 196 * MiB, "rec fits");
constexpr int CW_CNT = 0;
constexpr int CW_CUR = 64;
constexpr int CW_TILE = 128;

__device__ __forceinline__ unsigned f2bf(float f) { unsigned u = __builtin_bit_cast(unsigned, f); return (u + 0x7fffu + ((u >> 16) & 1u)) >> 16; }
__device__ __forceinline__ unsigned pk2(float lo, float hi) { return f2bf(lo) | (f2bf(hi) << 16); }
__device__ __forceinline__ float bf2f(unsigned b) { return __builtin_bit_cast(float, b << 16); }
__device__ __forceinline__ float bflo(unsigned w) { return __builtin_bit_cast(float, w << 16); }
__device__ __forceinline__ float bfhi(unsigned w) { return __builtin_bit_cast(float, w & 0xffff0000u); }
__device__ __forceinline__ unsigned cvt_pk_bf16(float lo, float hi) { unsigned r; asm volatile("v_cvt_pk_bf16_f32 %0, %1, %2" : "=v"(r) : "v"(lo), "v"(hi)); return r; }
__device__ __forceinline__ float wave_sum(float v) {
#pragma unroll
    for (int o = 1; o < 64; o <<= 1) v += __shfl_xor(v, o);
    return v;
}
__device__ __forceinline__ float wave_max(float v) {
#pragma unroll
    for (int o = 1; o < 64; o <<= 1) v = fmaxf(v, __shfl_xor(v, o));
    return v;
}
__device__ __forceinline__ float sigmoidf_(float x) { return 1.0f / (1.0f + __expf(-x)); }
__device__ __forceinline__ float softplusf_(float x) { return fmaxf(x, 0.f) + log1pf(__expf(-fabsf(x))); }
#define LDS_WAIT() asm volatile("s_waitcnt lgkmcnt(0)" ::: "memory")

namespace pg8 {
constexpr int BM = 256, BK = 64, HALF = 128, HTB = HALF * BK * 2, NXCD = 8, WGM = 8;
__device__ __forceinline__ int lds_byte(int r, int c) { const int st = (r >> 4) * 2 + (c >> 5), rr = r & 15, cc = c & 31, ob = rr * 64 + cc * 2; return st * 1024 + (ob ^ (((ob >> 9) & 1) << 5)); }
__device__ __forceinline__ void stage_rc(int b, int& R, int& C) { const int st = b / 1024, sb = b % 1024, swz = sb ^ (((sb >> 9) & 1) << 5); R = (st >> 1) * 16 + swz / 64; C = (st & 1) * 32 + (swz % 64) / 2; }
__device__ __forceinline__ int perm32(int rho) { const int n = rho >> 4, i = rho & 15; return 8 * (i >> 2) + 4 * n + (i & 3); }

struct Unit { int pm, pn, e; };

template <class Epi, class Sched>
__device__ __forceinline__ void gemm_phase(LAS unsigned char* lds, const Sched& S, const Epi& E) {
    int tid_ = threadIdx.x; asm volatile("" : "+v"(tid_)); const int tid = tid_, wid = __builtin_amdgcn_readfirstlane(tid >> 6), lane = tid & 63, wr = wid >> 2, wc = wid & 3, fr = lane & 15, fq = lane >> 4;
    const int K = S.K, nt = K / BK;
    unsigned voffA[2], voffB[2];
#pragma unroll
    for (int i = 0; i < 2; ++i) { int R, C; stage_rc(tid * 16 + i * 8192, R, C); const int Rb = Epi::PERM ? ((R & ~31) + perm32(R & 31)) : R;
        voffA[i] = (unsigned)(R * S.lda + C) * 2u; voffB[i] = (unsigned)(Rb * S.ldb + C) * 2u; }
    const size_t kstep = (size_t)(BK * 2);
    const size_t hstepA = (size_t)HALF * S.lda * 2, hstepB = (size_t)HALF * S.ldb * 2;
    const unsigned ldsw = (unsigned)wid * 1024u;
    const int aoff = lds_byte(wr * 64 + fr, fq * 8), boff = lds_byte(wc * 32 + fr, fq * 8);
#define PG8_SA(b, h) (((b) * 2 + (h)) * HTB)
#define PG8_SB(b, h) ((4 + (b) * 2 + (h)) * HTB)
#define PG8_STAGE(bufoff, gbase, voff) do { _Pragma("unroll") for (int _i = 0; _i < 2; ++_i) \
        __builtin_amdgcn_global_load_lds((const unsigned*)((const char*)(gbase) + (voff)[_i]), (LAS unsigned*)(lds + (bufoff) + ldsw + _i * 8192), 16, 0, 0); } while (0)
#define PG8_LDA(dst, b, h) do { _Pragma("unroll") for (int m = 0; m < 4; ++m) _Pragma("unroll") for (int k = 0; k < 2; ++k) dst[m][k] = *(const LAS bf16x8*)(lds + PG8_SA(b, h) + aoff + m * 2048 + k * 1024); } while (0)
#define PG8_LDB(dst, b, h) do { _Pragma("unroll") for (int n = 0; n < 2; ++n) _Pragma("unroll") for (int k = 0; k < 2; ++k) dst[n][k] = *(const LAS bf16x8*)(lds + PG8_SB(b, h) + boff + n * 2048 + k * 1024); } while (0)
#define PG8_MMA(ai, bj, At, Bt) do { __builtin_amdgcn_s_setprio(1); _Pragma("unroll") for (int m = 0; m < 4; ++m) _Pragma("unroll") for (int n = 0; n < 2; ++n) _Pragma("unroll") for (int k = 0; k < 2; ++k) \
        acc[ai][bj][m][n] = __builtin_amdgcn_mfma_f32_16x16x32_bf16(Bt[n][k], At[m][k], acc[ai][bj][m][n], 0, 0, 0); __builtin_amdgcn_s_setprio(0); } while (0)
#define PG8_WAIT_V(n) asm volatile("s_waitcnt vmcnt(" #n ")" ::: "memory")
#define PG8_WAIT_L(n) asm volatile("s_waitcnt lgkmcnt(" #n ")" ::: "memory")
#define PG8_BAR __builtin_amdgcn_s_barrier()
#define PG8_SCHED __builtin_amdgcn_sched_barrier(0)
    Unit cur, nxt; int ui = 0;
    if (!S.next(0, cur)) return;
    f32x4 acc[2][2][4][2];
#pragma unroll
    for (int a = 0; a < 2; ++a)
#pragma unroll
        for (int b = 0; b < 2; ++b)
#pragma unroll
            for (int m = 0; m < 4; ++m)
#pragma unroll
                for (int n = 0; n < 2; ++n) acc[a][b][m][n] = (f32x4){0.f, 0.f, 0.f, 0.f};
    bf16x8 At[4][2], B0[2][2], B1[2][2];
    const char* cA = S.aptr(cur); const char* cB = S.bptr(cur);
    PG8_STAGE(PG8_SB(0, 0), cB, voffB); PG8_STAGE(PG8_SA(0, 0), cA, voffA); PG8_STAGE(PG8_SB(0, 1), cB + hstepB, voffB); PG8_STAGE(PG8_SA(0, 1), cA + hstepA, voffA);
    if (wr == 1) PG8_BAR;
    PG8_WAIT_V(4); PG8_BAR;
    PG8_STAGE(PG8_SB(1, 0), cB + kstep, voffB); PG8_STAGE(PG8_SA(1, 0), cA + kstep, voffA); PG8_STAGE(PG8_SB(1, 1), cB + hstepB + kstep, voffB);
    PG8_WAIT_V(6); PG8_BAR;
    for (;;) {
        const bool has_next = S.next(ui + 1, nxt);
        const char* nA = has_next ? S.aptr(nxt) : cA; const char* nB = has_next ? S.bptr(nxt) : cB;
        for (int t = 0; t < nt; t += 2) {
            const bool last = (t == nt - 2);
            const char* a1 = cA + (size_t)(t + 1) * kstep;
            const char* a2 = last ? nA : cA + (size_t)(t + 2) * kstep; const char* b2 = last ? nB : cB + (size_t)(t + 2) * kstep;
            const char* a3 = a2 + kstep; const char* b3 = b2 + kstep;
            PG8_LDB(B0, 0, 0); PG8_SCHED; PG8_LDA(At, 0, 0); PG8_STAGE(PG8_SA(1, 1), a1 + hstepA, voffA);
            PG8_WAIT_L(8); PG8_BAR; PG8_WAIT_L(0); PG8_MMA(0, 0, At, B0); PG8_BAR; PG8_SCHED;
            PG8_LDB(B1, 0, 1); PG8_STAGE(PG8_SB(0, 0), b2, voffB);
            PG8_BAR; PG8_WAIT_L(0); PG8_MMA(0, 1, At, B1); PG8_BAR;
            PG8_LDA(At, 0, 1); PG8_STAGE(PG8_SA(0, 0), a2, voffA);
            PG8_BAR; PG8_WAIT_L(0); PG8_MMA(1, 0, At, B0); PG8_BAR; PG8_SCHED;
            PG8_STAGE(PG8_SB(0, 1), b2 + hstepB, voffB);
            PG8_WAIT_V(6); PG8_BAR; PG8_MMA(1, 1, At, B1); PG8_BAR;
            PG8_LDB(B0, 1, 0); PG8_SCHED; PG8_LDA(At, 1, 0); PG8_STAGE(PG8_SA(0, 1), a2 + hstepA, voffA);
            PG8_WAIT_L(8); PG8_BAR; PG8_WAIT_L(0); PG8_MMA(0, 0, At, B0); PG8_BAR; PG8_SCHED;
            PG8_LDB(B1, 1, 1); PG8_STAGE(PG8_SB(1, 0), b3, voffB);
            PG8_BAR; PG8_WAIT_L(0); PG8_MMA(0, 1, At, B1); PG8_BAR;
            PG8_LDA(At, 1, 1); PG8_STAGE(PG8_SA(1, 0), a3, voffA);
            PG8_BAR; PG8_WAIT_L(0); PG8_MMA(1, 0, At, B0); PG8_BAR; PG8_SCHED;
            PG8_STAGE(PG8_SB(1, 1), b3 + hstepB, voffB);
            PG8_WAIT_V(6); PG8_BAR; PG8_MMA(1, 1, At, B1); PG8_BAR;
        }
        if constexpr (!Epi::AFTER_DRAIN) { int fr_ = fr, fq_ = fq; asm volatile("" : "+v"(fr_), "+v"(fq_)); E(acc, cur, wr, wc, fr_, fq_); }
        if (!has_next) break;
#pragma unroll
        for (int a = 0; a < 2; ++a)
#pragma unroll
            for (int b = 0; b < 2; ++b)
#pragma unroll
                for (int m = 0; m < 4; ++m)
#pragma unroll
                    for (int n = 0; n < 2; ++n) acc[a][b][m][n] = (f32x4){0.f, 0.f, 0.f, 0.f};
        cur = nxt; cA = nA; cB = nB; ++ui;
    }
    PG8_WAIT_V(0);
    if (wr == 0) PG8_BAR;
    PG8_BAR;
    if constexpr (Epi::AFTER_DRAIN) { int fr_ = fr, fq_ = fq; asm volatile("" : "+v"(fr_), "+v"(fq_)); E.fused(acc, cur, wr, wc, fr_, fq_, lds, wid, lane); }
#undef PG8_SA
#undef PG8_SB
#undef PG8_STAGE
#undef PG8_LDA
#undef PG8_LDB
#undef PG8_MMA
#undef PG8_WAIT_V
#undef PG8_WAIT_L
#undef PG8_BAR
#undef PG8_SCHED
}

struct DenseOrder {
    const char* A; const char* Bt; int lda, ldb, K; int nM, nN, nwg, G, c;
    __device__ void init(const void* A_, const void* Bt_, int M, int N, int K_, int lda_, int ldb_, int G_, int c_) { A = (const char*)A_; Bt = (const char*)Bt_; K = K_; lda = lda_; ldb = ldb_; nM = M / BM; nN = N / BM; nwg = nM * nN; G = G_; c = c_; }
    __device__ bool next(int i, Unit& u) const {
        const long L = (long)i * G + c; if (L >= nwg) return false;
        int wgid = (int)L; { const int q = nwg / NXCD, r = nwg % NXCD, xcd = wgid % NXCD, off = wgid / NXCD; wgid = (xcd < r ? xcd * (q + 1) : r * (q + 1) + (xcd - r) * q) + off; }
        const int nig = WGM * nN, gid = wgid / nig, fm = gid * WGM, gsz = (nM - fm) < WGM ? (nM - fm) : WGM;
        u.pm = fm + ((wgid % nig) % gsz); u.pn = (wgid % nig) / gsz; u.e = 0; return true;
    }
    __device__ __forceinline__ const char* aptr(const Unit& u) const { return A + (size_t)u.pm * BM * lda * 2; }
    __device__ __forceinline__ const char* bptr(const Unit& u) const { return Bt + (size_t)u.pn * BM * ldb * 2; }
};
struct KvOrder {
    const char* memb; const char* wkv; int lda, ldb, K, G, c;
    __device__ bool next(int i, Unit& u) const {
        const int L = i * G + c; if (L >= 128) return false;
        const int layer = L >> 6, rem = L & 63;
        if (rem < 32) { u.pm = rem >> 2; u.pn = rem & 3; u.e = layer * 2; }
        else { u.pm = (rem - 32) >> 3; u.pn = (rem - 32) & 7; u.e = layer * 2 + 1; }
        return true;
    }
    __device__ __forceinline__ const char* aptr(const Unit& u) const {
        const int layer = u.e >> 1;
        return (u.e & 1) ? wkv + ((size_t)layer * 2048 + 1024 + (size_t)u.pm * 256) * 2048 : memb + (size_t)u.pm * 256 * 2048;
    }
    __device__ __forceinline__ const char* bptr(const Unit& u) const {
        const int layer = u.e >> 1;
        return (u.e & 1) ? memb + (size_t)u.pn * 256 * 2048 : wkv + ((size_t)layer * 2048 + (size_t)u.pn * 256) * 2048;
    }
};
struct SOrder {
    const char* Q; const char* Kb; int lda, ldb, K, G, c;
    __device__ bool next(int i, Unit& u) const { const int L = i * G + c; if (L >= 256) return false; u.pm = L & 7; u.pn = 0; u.e = L >> 3; return true; }
    __device__ __forceinline__ const char* aptr(const Unit& u) const { const int b = u.e >> 2, hd = u.e & 3; return Q + (((size_t)b * 2048 + (size_t)u.pm * 256) * 1024 + hd * 256) * 2; }
    __device__ __forceinline__ const char* bptr(const Unit& u) const { const int b = u.e >> 2, hd = u.e & 3; return Kb + (((size_t)b * 256) * 1024 + hd * 256) * 2; }
};
struct PvOrder {
    const char* P; const char* Vt; int lda, ldb, K, G, c;
    __device__ bool next(int i, Unit& u) const { const int L = i * G + c; if (L >= 256) return false; u.pm = L & 7; u.pn = 0; u.e = L >> 3; return true; }
    __device__ __forceinline__ const char* aptr(const Unit& u) const { return P + (((size_t)u.e * 2048 + (size_t)u.pm * 256) * 256) * 2; }
    __device__ __forceinline__ const char* bptr(const Unit& u) const { const int b = u.e >> 2, hd = u.e & 3; return Vt + (((size_t)hd * 256) * 2048 + (size_t)b * 256) * 2; }
};
struct MoeOrder {
    const char* A; const char* W; LAS const int* ul; size_t wstride; int lda, ldb, K;
    __device__ bool next(int i, Unit& u) const {
        if (i >= 16) return false;
        const int pm = __builtin_amdgcn_readfirstlane(ul[3 * i]); if (pm < 0) return false;
        u.pm = pm; u.pn = __builtin_amdgcn_readfirstlane(ul[3 * i + 1]); u.e = __builtin_amdgcn_readfirstlane(ul[3 * i + 2]); return true;
    }
    __device__ __forceinline__ const char* aptr(const Unit& u) const { return A + (size_t)u.pm * 256 * lda * 2; }
    __device__ __forceinline__ const char* bptr(const Unit& u) const { return W + (size_t)u.e * wstride + (size_t)u.pn * 256 * ldb * 2; }
};

struct EpiF32 {
    static constexpr bool PERM = false, AFTER_DRAIN = false;
    float* C; int ldc;
    __device__ __forceinline__ void operator()(const f32x4 (&acc)[2][2][4][2], const Unit& u, int wr, int wc, int fr, int fq) const {
        const int row0 = u.pm * BM + wr * 64 + fr, col0 = u.pn * BM + wc * 32 + 4 * fq;
#pragma unroll
        for (int ai = 0; ai < 2; ++ai)
#pragma unroll
            for (int m = 0; m < 4; ++m) { float* rowp = C + (size_t)(row0 + ai * HALF + m * 16) * ldc + col0;
#pragma unroll
                for (int bj = 0; bj < 2; ++bj)
#pragma unroll
                    for (int n = 0; n < 2; ++n) *(f32x4*)(rowp + bj * HALF + n * 16) = acc[ai][bj][m][n]; }
    }
};
__device__ __forceinline__ void store_bf16_tile(const f32x4 (&acc)[2][2][4][2], bf16_t* base, int ldc, float sc, int wr, int wc, int fr, int fq) {
    const int row0 = wr * 64 + fr, col0 = wc * 32 + 8 * fq;
#pragma unroll
    for (int ai = 0; ai < 2; ++ai)
#pragma unroll
        for (int m = 0; m < 4; ++m) { bf16_t* rowp = base + (size_t)(row0 + ai * HALF + m * 16) * ldc + col0;
#pragma unroll
            for (int bj = 0; bj < 2; ++bj) { const f32x4 v0 = acc[ai][bj][m][0] * sc, v1 = acc[ai][bj][m][1] * sc;
                u32x4 w; w.x = cvt_pk_bf16(v0[0], v0[1]); w.y = cvt_pk_bf16(v0[2], v0[3]); w.z = cvt_pk_bf16(v1[0], v1[1]); w.w = cvt_pk_bf16(v1[2], v1[3]);
                *(u32x4*)(rowp + bj * HALF) = w; } }
}
struct EpiBf16 {
    static constexpr bool PERM = true, AFTER_DRAIN = false;
    bf16_t* O; int ldc; float scale;
    __device__ __forceinline__ void operator()(const f32x4 (&acc)[2][2][4][2], const Unit& u, int wr, int wc, int fr, int fq) const {
        store_bf16_tile(acc, O + (size_t)u.pm * BM * ldc + u.pn * BM, ldc, scale, wr, wc, fr, fq);
    }
};
struct EpiProj {
    static constexpr bool PERM = true, AFTER_DRAIN = false;
    bf16_t* O; float* gates;
    __device__ __forceinline__ void operator()(const f32x4 (&acc)[2][2][4][2], const Unit& u, int wr, int wc, int fr, int fq) const {
        store_bf16_tile(acc, O + (size_t)u.pm * BM * NPROJ + u.pn * BM, NPROJ, 1.0f, wr, wc, fr, fq);
        if (u.pn == 15 && wc == 0 && fq == 0) {
#pragma unroll
            for (int ai = 0; ai < 2; ++ai)
#pragma unroll
                for (int m = 0; m < 4; ++m) { float* g = gates + (size_t)(u.pm * BM + ai * HALF + wr * 64 + m * 16 + fr) * 8;
                    *(f32x4*)g = acc[ai][0][m][0]; *(f32x4*)(g + 4) = acc[ai][0][m][1]; }
        }
    }
};
struct EpiKv {
    static constexpr bool PERM = true, AFTER_DRAIN = false;
    bf16_t* Kb; bf16_t* Vt;
    __device__ __forceinline__ void operator()(const f32x4 (&acc)[2][2][4][2], const Unit& u, int wr, int wc, int fr, int fq) const {
        const int layer = u.e >> 1;
        if (u.e & 1) store_bf16_tile(acc, Vt + (size_t)layer * 1024 * 2048 + (size_t)u.pm * BM * 2048 + u.pn * BM, 2048, 1.0f, wr, wc, fr, fq);
        else store_bf16_tile(acc, Kb + (size_t)layer * 2048 * 1024 + (size_t)u.pm * BM * 1024 + u.pn * BM, 1024, 1.0f, wr, wc, fr, fq);
    }
};
struct EpiPv {
    static constexpr bool PERM = true, AFTER_DRAIN = false;
    bf16_t* O;
    __device__ __forceinline__ void operator()(const f32x4 (&acc)[2][2][4][2], const Unit& u, int wr, int wc, int fr, int fq) const {
        const int b = u.e >> 2, hd = u.e & 3;
        store_bf16_tile(acc, O + ((size_t)b * 2048 + (size_t)u.pm * 256) * 1024 + hd * 256, 1024, 1.0f, wr, wc, fr, fq);
    }
};
struct EpiSoftmax {
    static constexpr bool PERM = true, AFTER_DRAIN = true;
    bf16_t* P;
    __device__ __forceinline__ void fused(f32x4 (&acc)[2][2][4][2], const Unit& u, int wr, int wc, int fr, int fq, LAS unsigned char* lds, int wid, int lane) const {
        LAS f32x2* tab = (LAS f32x2*)lds;
#pragma unroll
        for (int ai = 0; ai < 2; ++ai)
#pragma unroll
            for (int m = 0; m < 4; ++m) {
                float mx = -3.0e38f;
#pragma unroll
                for (int bj = 0; bj < 2; ++bj)
#pragma unroll
                    for (int n = 0; n < 2; ++n) { const f32x4 x = acc[ai][bj][m][n]; mx = fmaxf(mx, fmaxf(fmaxf(x[0], x[1]), fmaxf(x[2], x[3]))); }
                mx = fmaxf(mx, __shfl_xor(mx, 16)); mx = fmaxf(mx, __shfl_xor(mx, 32));
                float s = 0.f;
#pragma unroll
                for (int bj = 0; bj < 2; ++bj)
#pragma unroll
                    for (int n = 0; n < 2; ++n) { const f32x4 x = acc[ai][bj][m][n]; s += (__expf(x[0] - mx) + __expf(x[1] - mx)) + (__expf(x[2] - mx) + __expf(x[3] - mx)); }
                s += __shfl_xor(s, 16); s += __shfl_xor(s, 32);
                if (fq == 0) tab[(ai * HALF + wr * 64 + m * 16 + fr) * 4 + wc] = (f32x2){mx, s};
            }
        LDS_WAIT(); __builtin_amdgcn_s_barrier(); asm volatile("" ::: "memory");
        bf16_t* base = P + ((size_t)u.e * 2048 + (size_t)u.pm * 256) * 256;
#pragma unroll
        for (int ai = 0; ai < 2; ++ai)
#pragma unroll
            for (int m = 0; m < 4; ++m) { const int r = ai * HALF + wr * 64 + m * 16 + fr;
                const f32x2 p0 = tab[r * 4 + 0], p1 = tab[r * 4 + 1], p2 = tab[r * 4 + 2], p3 = tab[r * 4 + 3];
                const float M = fmaxf(fmaxf(p0.x, p1.x), fmaxf(p2.x, p3.x));
                const float ssum = p0.y * __expf(p0.x - M) + p1.y * __expf(p1.x - M) + p2.y * __expf(p2.x - M) + p3.y * __expf(p3.x - M);
                const float inv = 1.0f / ssum;
                bf16_t* rowp = base + (size_t)r * 256 + wc * 32 + 8 * fq;
#pragma unroll
                for (int bj = 0; bj < 2; ++bj) { const f32x4 x0 = acc[ai][bj][m][0], x1 = acc[ai][bj][m][1];
                    u32x4 w; w.x = cvt_pk_bf16(__expf(x0[0] - M) * inv, __expf(x0[1] - M) * inv); w.y = cvt_pk_bf16(__expf(x0[2] - M) * inv, __expf(x0[3] - M) * inv);
                    w.z = cvt_pk_bf16(__expf(x1[0] - M) * inv, __expf(x1[1] - M) * inv); w.w = cvt_pk_bf16(__expf(x1[2] - M) * inv, __expf(x1[3] - M) * inv);
                    *(u32x4*)(rowp + bj * HALF) = w; } }
        LDS_WAIT(); __builtin_amdgcn_s_barrier(); asm volatile("" ::: "memory");
    }
};
struct EpiSwiglu {
    static constexpr bool PERM = true, AFTER_DRAIN = false;
    bf16_t* G; const float* b1;
    __device__ __forceinline__ void operator()(const f32x4 (&acc)[2][2][4][2], const Unit& u, int wr, int wc, int fr, int fq) const {
        const int cin = wc * 32 + 8 * fq;
        const float* bg = b1 + (size_t)u.e * 2048 + u.pn * 128 + cin; const float* bu = bg + 1024;
        const f32x4 g0 = *(const f32x4*)bg, g1 = *(const f32x4*)(bg + 4), u0 = *(const f32x4*)bu, u1 = *(const f32x4*)(bu + 4);
#pragma unroll
        for (int ai = 0; ai < 2; ++ai)
#pragma unroll
            for (int m = 0; m < 4; ++m) {
                bf16_t* rowp = G + (size_t)(u.pm * BM + ai * HALF + wr * 64 + m * 16 + fr) * 1024 + u.pn * 128 + cin;
                float o[8];
#pragma unroll
                for (int n = 0; n < 2; ++n) { const f32x4 ga = acc[ai][0][m][n] + (n ? g1 : g0), up = acc[ai][1][m][n] + (n ? u1 : u0);
#pragma unroll
                    for (int j = 0; j < 4; ++j) { const float gt = fminf(ga[j], 7.0f), uu = fminf(fmaxf(up[j], -7.0f), 7.0f);
                        const float glu = gt / (1.0f + __expf(-1.702f * gt)); o[n * 4 + j] = (uu + 1.0f) * glu; } }
                u32x4 w; w.x = cvt_pk_bf16(o[0], o[1]); w.y = cvt_pk_bf16(o[2], o[3]); w.z = cvt_pk_bf16(o[4], o[5]); w.w = cvt_pk_bf16(o[6], o[7]);
                *(u32x4*)rowp = w; }
    }
};
struct EpiMoeY {
    static constexpr bool PERM = true, AFTER_DRAIN = false;
    bf16_t* Y; const float* b2;
    __device__ __forceinline__ void operator()(const f32x4 (&acc)[2][2][4][2], const Unit& u, int wr, int wc, int fr, int fq) const {
        const int col0 = u.pn * BM + wc * 32 + 8 * fq;
        f32x4 bv[2][2];
#pragma unroll
        for (int bj = 0; bj < 2; ++bj)
#pragma unroll
            for (int n = 0; n < 2; ++n) bv[bj][n] = *(const f32x4*)(b2 + (size_t)u.e * 1024 + col0 + bj * HALF + 4 * n);
#pragma unroll
        for (int ai = 0; ai < 2; ++ai)
#pragma unroll
            for (int m = 0; m < 4; ++m) { bf16_t* rowp = Y + (size_t)(u.pm * BM + ai * HALF + wr * 64 + m * 16 + fr) * 1024 + col0;
#pragma unroll
                for (int bj = 0; bj < 2; ++bj) { const f32x4 v0 = acc[ai][bj][m][0] + bv[bj][0], v1 = acc[ai][bj][m][1] + bv[bj][1];
                    u32x4 w; w.x = cvt_pk_bf16(v0[0], v0[1]); w.y = cvt_pk_bf16(v0[2], v0[3]); w.z = cvt_pk_bf16(v1[0], v1[1]); w.w = cvt_pk_bf16(v1[2], v1[3]);
                    *(u32x4*)(rowp + bj * HALF) = w; } }
    }
};
}

struct Args { const float* in[37]; float* out; unsigned char* ws; int ph_lo, ph_hi; };
constexpr int TAB_OFF = MISC_OFF + 8192;
struct InTab {
    LAS const volatile unsigned* t;
    __device__ __forceinline__ const void* get(int k) const { unsigned lo = t[2 * k], hi = t[2 * k + 1]; lo = __builtin_amdgcn_readfirstlane(lo); hi = __builtin_amdgcn_readfirstlane(hi); return (const void*)(((unsigned long long)hi << 32) | lo); }
    __device__ __forceinline__ const float* operator[](int k) const { return (const float*)get(k); }
};
struct Ctx {
    LAS unsigned char* lds; int tid, lane, wave, blk, G, gw, ngw;
    InTab in; float* out; unsigned char* ws;
};
template <class Tp> __device__ __forceinline__ Tp* wsp(const Ctx& F, size_t off) { return (Tp*)(F.ws + off); }

__device__ __forceinline__ void ln_row_store(f32x4 (&v)[4], const float* g, const float* b, float* hrow, bf16_t* hbrow, int lane) {
    float s = 0.f;
#pragma unroll
    for (int j = 0; j < 4; ++j) s += (v[j][0] + v[j][1]) + (v[j][2] + v[j][3]);
    const float mean = wave_sum(s) * (1.0f / 1024.0f); float s2 = 0.f;
#pragma unroll
    for (int j = 0; j < 4; ++j) { v[j] = v[j] - mean; s2 += (v[j][0] * v[j][0] + v[j][1] * v[j][1]) + (v[j][2] * v[j][2] + v[j][3] * v[j][3]); }
    const float rstd = 1.0f / sqrtf(wave_sum(s2) * (1.0f / 1024.0f) + 1e-5f);
#pragma unroll
    for (int j = 0; j < 4; ++j) {
        const f32x4 gg = *(const f32x4*)(g + 256 * j + 4 * lane), bb = *(const f32x4*)(b + 256 * j + 4 * lane);
        const f32x4 o = v[j] * rstd * gg + bb;
        *(f32x4*)(hrow + 256 * j + 4 * lane) = o;
        if (hbrow) { u32x2 w; w.x = pk2(o[0], o[1]); w.y = pk2(o[2], o[3]); *(u32x2*)(hbrow + 256 * j + 4 * lane) = w; }
    }
}

__device__ __forceinline__ int map_row(int kind, int n) {
    if (kind == 1) return n < 2048 ? n : (n < 2056 ? 3840 + (n - 2048) : n - 8);
    if (kind == 2) { const int j = n & 1023; return (j >> 7) * 256 + ((n >> 10) << 7) + (j & 127); }
    return n;
}
__device__ __forceinline__ void transpose_item(const float* W, int N, bf16_t* WT, int kind, LAS float* scr, int item, int lane) {
    const int nblk = (N + 63) >> 6, kb = item / nblk, nb = item % nblk, k0 = 64 * kb, n0 = 64 * nb;
    const int kl = lane >> 4, n4 = (lane & 15) * 4; const bool ok = (n0 + n4) < N;
    f32x4 v[16];
#pragma unroll
    for (int i = 0; i < 16; ++i) v[i] = ok ? *(const f32x4*)(W + (size_t)(k0 + 4 * i + kl) * N + n0 + n4) : (f32x4){0.f, 0.f, 0.f, 0.f};
#pragma unroll
    for (int i = 0; i < 16; ++i) { LAS float* d = scr + (4 * i + kl) * 65 + n4; d[0] = v[i][0]; d[1] = v[i][1]; d[2] = v[i][2]; d[3] = v[i][3]; }
    LDS_WAIT(); asm volatile("" ::: "memory");
    const int c = lane & 7;
#pragma unroll
    for (int j = 0; j < 8; ++j) { const int n = (lane >> 3) + 8 * j; const LAS float* sp = scr + (8 * c) * 65 + n;
        if (n0 + n < N) { u32x4 o; o.x = cvt_pk_bf16(sp[0 * 65], sp[1 * 65]); o.y = cvt_pk_bf16(sp[2 * 65], sp[3 * 65]); o.z = cvt_pk_bf16(sp[4 * 65], sp[5 * 65]); o.w = cvt_pk_bf16(sp[6 * 65], sp[7 * 65]);
            *(u32x4*)(WT + (size_t)map_row(kind, n0 + n) * 1024 + k0 + 8 * c) = o; } }
    LDS_WAIT(); asm volatile("" ::: "memory");
}
__device__ __forceinline__ void phase_prologue(const Ctx& F) {
    LAS float* scr = (LAS float*)(F.lds + F.wave * 16640);
    constexpr int I_IN = 16 * 61, I_SQ = 16 * 16, I_KV = 16 * 32, I_W1 = 16 * 32, I_W2 = 16 * 16;
    constexpr int PER_LAYER = I_IN + 3 * I_SQ + I_KV + 32 * I_W1 + 32 * I_W2;
    const float* p_win = F.in[4]; const float* p_wout = F.in[21]; const float* p_wq = F.in[24]; const float* p_wkv = F.in[25]; const float* p_wo = F.in[26]; const float* p_w1 = F.in[31]; const float* p_w2 = F.in[33];
    for (int it = F.gw; it < 2 * PER_LAYER; it += F.ngw) {
        const int l = it / PER_LAYER; int r = it % PER_LAYER;
        if (r < I_IN) { transpose_item(p_win + (size_t)l * 1024 * IN_COLS, IN_COLS, wsp<bf16_t>(F, WS_WIN) + (size_t)l * 4096 * 1024, 1, scr, r, F.lane); continue; } r -= I_IN;
        if (r < I_SQ) { transpose_item(p_wout + (size_t)l * 1024 * 1024, 1024, wsp<bf16_t>(F, WS_WOUT) + (size_t)l * 1024 * 1024, 0, scr, r, F.lane); continue; } r -= I_SQ;
        if (r < I_SQ) { transpose_item(p_wq + (size_t)l * 1024 * 1024, 1024, wsp<bf16_t>(F, WS_WQ) + (size_t)l * 1024 * 1024, 0, scr, r, F.lane); continue; } r -= I_SQ;
        if (r < I_KV) { transpose_item(p_wkv + (size_t)l * 1024 * 2048, 2048, wsp<bf16_t>(F, WS_WKV) + (size_t)l * 2048 * 1024, 0, scr, r, F.lane); continue; } r -= I_KV;
        if (r < I_SQ) { transpose_item(p_wo + (size_t)l * 1024 * 1024, 1024, wsp<bf16_t>(F, WS_WO) + (size_t)l * 1024 * 1024, 0, scr, r, F.lane); continue; } r -= I_SQ;
        if (r < 32 * I_W1) { const int e = r / I_W1; transpose_item(p_w1 + ((size_t)l * 32 + e) * 1024 * 2048, 2048, wsp<bf16_t>(F, WS_W1) + ((size_t)l * 32 + e) * 2048 * 1024, 2, scr, r % I_W1, F.lane); continue; } r -= 32 * I_W1;
        { const int e = r / I_W2; transpose_item(p_w2 + ((size_t)l * 32 + e) * 1024 * 1024, 1024, wsp<bf16_t>(F, WS_W2) + ((size_t)l * 32 + e) * 1024 * 1024, 0, scr, r % I_W2, F.lane); }
    }
    const int gt = F.blk * NTHREADS + F.tid, ngt = F.G * NTHREADS;
    for (int i = gt; i < 2 * 248 * 128; i += ngt) { const int l = i / (248 * 128), r = i % (248 * 128); *(u32x4*)(wsp<bf16_t>(F, WS_WIN) + ((size_t)l * 4096 + 3848) * 1024 + (size_t)r * 8) = (u32x4){0u, 0u, 0u, 0u}; }
    const float* pw2 = F.in[12]; const float* pa2 = F.in[14]; const float* pg2 = F.in[15];
    for (int i = gt; i < 2 * 1536 * 256; i += ngt) {
        const int l = i / (1536 * 256), r = i % (1536 * 256), n = r >> 8, k = r & 255; float v = 0.f;
        if (n < 512) { if (k < 64) v = pw2[((size_t)l * 64 + k) * 512 + n]; }
        else if (n < 1024) { if (k >= 64 && k < 128) v = pa2[((size_t)l * 64 + (k - 64)) * 512 + (n - 512)]; }
        else { if (k >= 128) v = pg2[((size_t)l * 128 + (k - 128)) * 512 + (n - 1024)]; }
        wsp<bf16_t>(F, WS_WLR)[i] = (bf16_t)f2bf(v);
    }
    const f32x4* pmem = (const f32x4*)F.in[1];
    for (int i = gt; i < 2048 * 1024 / 4; i += ngt) { const f32x4 v = pmem[i]; u32x2 w; w.x = pk2(v[0], v[1]); w.y = pk2(v[2], v[3]); ((u32x2*)wsp<bf16_t>(F, WS_MEMB))[i] = w; }
    const float* px = F.in[0]; const float* pg0 = F.in[2]; const float* pb0 = F.in[3];
    for (int m = F.gw; m < T_TOK; m += F.ngw) {
        f32x4 v[4]; const float* xr = px + (size_t)m * DM;
#pragma unroll
        for (int j = 0; j < 4; ++j) v[j] = *(const f32x4*)(xr + 256 * j + 4 * F.lane);
        ln_row_store(v, pg0, pb0, wsp<float>(F, WS_H) + (size_t)m * DM, wsp<bf16_t>(F, WS_HB) + (size_t)m * DM, F.lane);
    }
}

__device__ __forceinline__ void phase_ln_add(const Ctx& F, const float* g, const float* b) {
    for (int m = F.gw; m < T_TOK; m += F.ngw) {
        f32x4 v[4]; const float* hr = wsp<float>(F, WS_H) + (size_t)m * DM; const float* cr = wsp<float>(F, WS_CF) + (size_t)m * DM;
#pragma unroll
        for (int j = 0; j < 4; ++j) v[j] = *(const f32x4*)(hr + 256 * j + 4 * F.lane) * DN_ALPHA + *(const f32x4*)(cr + 256 * j + 4 * F.lane);
        ln_row_store(v, g, b, wsp<float>(F, WS_H) + (size_t)m * DM, wsp<bf16_t>(F, WS_HB) + (size_t)m * DM, F.lane);
    }
}
__device__ __forceinline__ void phase_ln_moe(const Ctx& F, const float* g, const float* b, bool last) {
    const int* slot = wsp<int>(F, SM_SLOT); const float* tg = wsp<float>(F, SM_TOPG); const bf16_t* Y = wsp<bf16_t>(F, WS_YB);
    for (int m = F.gw; m < T_TOK; m += F.ngw) {
        f32x4 v[4]; const float* hr = wsp<float>(F, WS_H) + (size_t)m * DM;
#pragma unroll
        for (int j = 0; j < 4; ++j) v[j] = *(const f32x4*)(hr + 256 * j + 4 * F.lane) * DN_ALPHA;
#pragma unroll
        for (int k = 0; k < 4; ++k) { const int sl = slot[m * 4 + k]; const float gk = tg[m * 4 + k]; const bf16_t* yr = Y + (size_t)sl * DM;
#pragma unroll
            for (int j = 0; j < 4; ++j) { const u32x2 w = *(const u32x2*)(yr + 256 * j + 4 * F.lane);
                v[j][0] += gk * bflo(w.x); v[j][1] += gk * bfhi(w.x); v[j][2] += gk * bflo(w.y); v[j][3] += gk * bfhi(w.y); } }
        float* dst = last ? F.out + (size_t)m * DM : wsp<float>(F, WS_H) + (size_t)m * DM;
        ln_row_store(v, g, b, dst, last ? (bf16_t*)nullptr : wsp<bf16_t>(F, WS_HB) + (size_t)m * DM, F.lane);
    }
}

__device__ __forceinline__ void phase_xlr(const Ctx& F, int l) {
    const bf16_t* proj = wsp<bf16_t>(F, WS_PROJ); bf16_t* xlr = wsp<bf16_t>(F, WS_XLR); const float* mu = F.in[10] + (size_t)l * 1792 + 1536;
    const int gt = F.blk * NTHREADS + F.tid, ngt = F.G * NTHREADS;
    for (int i = gt; i < T_TOK * 32; i += ngt) {
        const int t = i >> 5, c8 = (i & 31) * 8;
        const u32x4 p = *(const u32x4*)(proj + (size_t)t * NPROJ + RC0 + 1536 + c8);
        u32x4 q = (u32x4){0u, 0u, 0u, 0u}; if ((t & (SEQ - 1)) != 0) q = *(const u32x4*)(proj + (size_t)(t - 1) * NPROJ + RC0 + 1536 + c8);
        float o[8];
#pragma unroll
        for (int j = 0; j < 4; ++j) { const float a0 = bflo(p[j]), a1 = bfhi(p[j]), b0 = bflo(q[j]), b1 = bfhi(q[j]);
            o[2 * j] = a0 + (b0 - a0) * mu[c8 + 2 * j]; o[2 * j + 1] = a1 + (b1 - a1) * mu[c8 + 2 * j + 1]; }
#pragma unroll
        for (int j = 0; j < 8; ++j) { if (c8 < 64) o[j] = tanhf(o[j]); else if (c8 >= 128) o[j] = sigmoidf_(o[j]); }
        u32x4 w; w.x = pk2(o[0], o[1]); w.y = pk2(o[2], o[3]); w.z = pk2(o[4], o[5]); w.w = pk2(o[6], o[7]);
        *(u32x4*)(xlr + (size_t)t * 256 + c8) = w;
    }
}

template <int CTRL> __device__ __forceinline__ float dpp_f(float x) { return __builtin_bit_cast(float, __builtin_amdgcn_update_dpp(0, __builtin_bit_cast(int, x), CTRL, 0xF, 0xF, true)); }
__device__ __forceinline__ float allreduce16(float x) { x += dpp_f<0x128>(x); x += dpp_f<0x124>(x); x += dpp_f<0x122>(x); x += dpp_f<0x121>(x); return x; }
__device__ __forceinline__ f32x4 bf4(u32x2 w) { return (f32x4){bflo(w.x), bfhi(w.x), bflo(w.y), bfhi(w.y)}; }
__device__ __forceinline__ float hsum4(f32x4 v) { return (v[0] + v[1]) + (v[2] + v[3]); }
__device__ __forceinline__ void phase_rwkv_prep(const Ctx& F, int l) {
    const bf16_t* proj = wsp<bf16_t>(F, WS_PROJ); const float* lr = wsp<float>(F, WS_LR); float* rec = wsp<float>(F, WS_REC); float* gv = wsp<float>(F, WS_GV); float* bon = wsp<float>(F, SM_BON);
    const float* mu = F.in[10] + (size_t)l * 1792; const float* w0 = F.in[11] + l * 512; const float* a0 = F.in[13] + l * 512;
    const float* pkk = F.in[16] + l * 512; const float* pka = F.in[17] + l * 512; const float* prk = F.in[18] + l * 512;
    const int r = F.lane >> 4, g = F.lane & 15;
    for (int item = F.gw; item < T_TOK * 2; item += F.ngw) {
        const int t = item >> 1, h = (item & 1) * 4 + r, c = h * 64 + 4 * g, s = t & (SEQ - 1), bh = (t >> 11) * 8 + h;
        const bf16_t* pr = proj + (size_t)t * NPROJ + RC0 + c; const bool hasp = s != 0;
        f32x4 xr = bf4(*(const u32x2*)pr), xk = bf4(*(const u32x2*)(pr + 512)), xv = bf4(*(const u32x2*)(pr + 1024));
        f32x4 yr = (f32x4){0.f, 0.f, 0.f, 0.f}, yk = yr, yv = yr;
        if (hasp) { yr = bf4(*(const u32x2*)(pr - NPROJ)); yk = bf4(*(const u32x2*)(pr + 512 - NPROJ)); yv = bf4(*(const u32x2*)(pr + 1024 - NPROJ)); }
        xr = xr + (yr - xr) * *(const f32x4*)(mu + c); xk = xk + (yk - xk) * *(const f32x4*)(mu + 512 + c); xv = xv + (yv - xv) * *(const f32x4*)(mu + 1024 + c);
        const float* lrow = lr + (size_t)t * 1536 + c;
        const f32x4 wpre = *(const f32x4*)(w0 + c) + *(const f32x4*)lrow, apre = *(const f32x4*)(a0 + c) + *(const f32x4*)(lrow + 512), gg = *(const f32x4*)(lrow + 1024);
        const f32x4 vkk = *(const f32x4*)(pkk + c), vka = *(const f32x4*)(pka + c), vrk = *(const f32x4*)(prk + c);
        f32x4 d, a, kk, kp, beta;
#pragma unroll
        for (int j = 0; j < 4; ++j) { const float wl = -softplusf_(-wpre[j]) - 0.5f; d[j] = __expf(-__expf(wl)); a[j] = sigmoidf_(apre[j]); kk[j] = xk[j] * vkk[j]; kp[j] = xk[j] * (1.0f + (a[j] - 1.0f) * vka[j]); }
        const float nrm = sqrtf(allreduce16(hsum4(kk * kk))); const float inv = 1.0f / fmaxf(nrm, 1e-12f);
        kk = kk * inv; beta = kk * a;
        const float c1 = allreduce16(hsum4(beta * xr)), c2 = allreduce16(hsum4(kp * xr)), bs = allreduce16(hsum4(xr * kp * vrk));
        float* rp = rec + ((size_t)bh * SEQ + s) * RECF + 4 * g;
        *(f32x4*)rp = -kk; *(f32x4*)(rp + 64) = beta; *(f32x4*)(rp + 128) = d; *(f32x4*)(rp + 192) = kp; *(f32x4*)(rp + 256) = d * xr; *(f32x4*)(rp + 320) = xv;
        if (g == 0) { *(f32x4*)(rp + 384) = (f32x4){c1, c2, 0.f, 0.f}; bon[t * 8 + h] = bs; }
        *(f32x4*)(gv + (size_t)t * 512 + c) = gg;
    }
}

__device__ __forceinline__ void phase_rwkv_scan(const Ctx& F) {
    if (F.blk >= 128) return;
    constexpr int TB = 16, CHF = TB * RECF, CH4 = CHF / 4;
    LAS float* buf = (LAS float*)F.lds;
    LAS float* ybuf = (LAS float*)(F.lds + 2 * CHF * 4);
    const int bh = F.blk >> 1, half = F.blk & 1, b = bh >> 3, h = bh & 7;
    const int r = F.lane >> 4, g = F.lane & 15, rowl = F.wave * 4 + r;
    const float* recbase = wsp<float>(F, WS_REC) + (size_t)bh * SEQ * RECF;
    float* yout = wsp<float>(F, WS_YR);
    for (int i = F.tid; i < CH4; i += NTHREADS) ((LAS f32x4*)buf)[i] = ((const f32x4*)recbase)[i];
    __syncthreads();
    f32x4 S = (f32x4){0.f, 0.f, 0.f, 0.f};
    for (int ci = 0; ci < SEQ / TB; ++ci) {
        f32x4 pre[4];
        if (ci + 1 < SEQ / TB) {
#pragma unroll
            for (int q = 0; q < 4; ++q) { const int idx = F.tid + q * NTHREADS; if (idx < CH4) pre[q] = ((const f32x4*)(recbase + (size_t)(ci + 1) * CHF))[idx]; }
        }
        const LAS float* cur = buf + (ci & 1) * CHF; LAS float* yb = ybuf + (ci & 1) * (TB * 32);
#define RW_LD(R, st_) do { const LAS float* rp_ = cur + (st_) * RECF; R##nk = *(const LAS f32x4*)(rp_ + 4 * g); R##be = *(const LAS f32x4*)(rp_ + 64 + 4 * g); R##dd = *(const LAS f32x4*)(rp_ + 128 + 4 * g); \
            R##kp = *(const LAS f32x4*)(rp_ + 192 + 4 * g); R##dr = *(const LAS f32x4*)(rp_ + 256 + 4 * g); R##vv = rp_[320 + half * 32 + rowl]; R##cc = *(const LAS f32x2*)(rp_ + 384); } while (0)
        f32x4 A_nk, A_be, A_dd, A_kp, A_dr, B_nk, B_be, B_dd, B_kp, B_dr; float A_vv, B_vv; f32x2 A_cc, B_cc;
        RW_LD(A_, 0);
#pragma unroll
        for (int st = 0; st < TB; ++st) {
            if (st + 1 < TB) RW_LD(B_, st + 1);
            __builtin_amdgcn_sched_barrier(0);
            float sa = (S[0] * A_nk[0] + S[1] * A_nk[1]) + (S[2] * A_nk[2] + S[3] * A_nk[3]);
            float p = (S[0] * A_dr[0] + S[1] * A_dr[1]) + (S[2] * A_dr[2] + S[3] * A_dr[3]);
            sa = allreduce16(sa); p = allreduce16(p);
            S = S * A_dd + (A_be * sa + A_kp * A_vv);
            const float y = p + sa * A_cc[0] + A_vv * A_cc[1];
            if (g == 0) yb[st * 32 + rowl] = y;
            A_nk = B_nk; A_be = B_be; A_dd = B_dd; A_kp = B_kp; A_dr = B_dr; A_vv = B_vv; A_cc = B_cc;
        }
#undef RW_LD
        if (ci + 1 < SEQ / TB) {
#pragma unroll
            for (int q = 0; q < 4; ++q) { const int idx = F.tid + q * NTHREADS; if (idx < CH4) ((LAS f32x4*)(buf + ((ci + 1) & 1) * CHF))[idx] = pre[q]; }
        }
        __syncthreads();
        { const int st = F.tid >> 5, rr = F.tid & 31; yout[((size_t)b * SEQ + ci * TB + st) * 512 + h * 64 + half * 32 + rr] = yb[F.tid]; }
    }
}
__device__ __forceinline__ void phase_rwkv_post(const Ctx& F, int l) {
    const float* yr = wsp<float>(F, WS_YR); const float* rec = wsp<float>(F, WS_REC); const float* gv = wsp<float>(F, WS_GV); const float* bon = wsp<float>(F, SM_BON);
    const float* gng = F.in[19] + l * 512; const float* gnb = F.in[20] + l * 512; bf16_t* mixed = wsp<bf16_t>(F, WS_MIXED);
    for (int item = F.gw; item < T_TOK * 8; item += F.ngw) {
        const int t = item >> 3, h = item & 7, c = h * 64 + F.lane, s = t & (SEQ - 1), bh = (t >> 11) * 8 + h;
        const float y = yr[(size_t)t * 512 + c];
        const float mean = wave_sum(y) * (1.0f / 64.0f); const float dv = y - mean;
        const float var = wave_sum(dv * dv) * (1.0f / 64.0f);
        const float yn = dv * (1.0f / sqrtf(var + 64e-5f)) * gng[c] + gnb[c];
        const float v = rec[((size_t)bh * SEQ + s) * RECF + 320 + F.lane];
        const float o = (yn + bon[t * 8 + h] * v) * gv[(size_t)t * 512 + c];
        mixed[(size_t)t * DM + 512 + c] = (bf16_t)f2bf(o);
    }
}

__device__ __forceinline__ void conv8(const bf16_t* proj, int t, int sabs, int col, const float* cw, const float* cb, float (&o)[2][8]) {
    float x[5][8];
#pragma unroll
    for (int i = 0; i < 5; ++i) { const int sa = sabs - 3 + i; u32x4 w = (u32x4){0u, 0u, 0u, 0u}; if (sa >= 0) w = *(const u32x4*)(proj + (size_t)(t - 3 + i) * NPROJ + col);
#pragma unroll
        for (int j = 0; j < 4; ++j) { x[i][2 * j] = bflo(w[j]); x[i][2 * j + 1] = bfhi(w[j]); } }
#pragma unroll
    for (int e = 0; e < 8; ++e) { const float w0 = cw[0 * 1024 + col + e], w1 = cw[1 * 1024 + col + e], w2 = cw[2 * 1024 + col + e], w3 = cw[3 * 1024 + col + e], bb = cb[col + e];
#pragma unroll
        for (int rr = 0; rr < 2; ++rr) { const float a = x[rr][e] * w0 + x[rr + 1][e] * w1 + x[rr + 2][e] * w2 + x[rr + 3][e] * w3 + bb; o[rr][e] = a * sigmoidf_(a); } }
}
__device__ __forceinline__ void phase_mlstm_prep(const Ctx& F, int l) {
    const bf16_t* proj = wsp<bf16_t>(F, WS_PROJ); const float* gates = wsp<float>(F, SM_GATES);
    bf16_t* qc = wsp<bf16_t>(F, WS_QC); bf16_t* kc = wsp<bf16_t>(F, WS_KC);
    float* bcum = wsp<float>(F, SM_BCUM); float* iga = wsp<float>(F, SM_IGA); float* mloc = wsp<float>(F, SM_MLOC); float* blast = wsp<float>(F, SM_BLAST);
    float* cloc = wsp<float>(F, WS_CLOC); float* nloc = wsp<float>(F, SM_NLOC);
    const float* cw = F.in[5] + (size_t)l * 4 * 1024; const float* cb = F.in[6] + (size_t)l * 1024; const float* igb = F.in[7] + l * 4; const float* fgb = F.in[8] + l * 4;
    LAS bf16_t* KT = (LAS bf16_t*)F.lds;
    LAS bf16_t* VT = (LAS bf16_t*)(F.lds + 18432);
    LAS float* wsrc = (LAS float*)(F.lds + 36864);
    for (int u = F.blk; u < 1024; u += F.G) {
        const int bh = u >> 5, c = u & 31, b = bh >> 2, h = bh & 3, t0 = b * SEQ + c * 64;
        if (F.wave == 0) {
            const int t = t0 + F.lane;
            const float ig = gates[(size_t)t * 8 + h] + igb[h]; const float f = gates[(size_t)t * 8 + 4 + h] + fgb[h];
            float x = -softplusf_(-f);
#pragma unroll
            for (int o = 1; o < 64; o <<= 1) { const float y = __shfl_up(x, o); if (F.lane >= o) x += y; }
            const float bl = __shfl(x, 63); const float src = bl - x + ig; const float ml = wave_max(src);
            wsrc[F.lane] = __expf(src - ml); bcum[(size_t)t * 4 + h] = x; iga[(size_t)t * 4 + h] = ig;
            if (F.lane == 0) { mloc[u] = ml; blast[u] = bl; }
        }
        __syncthreads();
        {
            const int jj = (F.tid & 15) * 8, s0 = (F.tid >> 4) * 2, t = t0 + s0, sabs = c * 64 + s0;
            float o[2][8];
            conv8(proj, t, sabs, h * 128 + jj, cw, cb, o);
#pragma unroll
            for (int rr = 0; rr < 2; ++rr) { u32x4 w; w.x = pk2(o[rr][0], o[rr][1]); w.y = pk2(o[rr][2], o[rr][3]); w.z = pk2(o[rr][4], o[rr][5]); w.w = pk2(o[rr][6], o[rr][7]);
                *(u32x4*)(qc + (size_t)(t + rr) * 512 + h * 128 + jj) = w; }
            conv8(proj, t, sabs, 512 + h * 128 + jj, cw, cb, o);
#pragma unroll
            for (int rr = 0; rr < 2; ++rr) { unsigned kb[8];
#pragma unroll
                for (int e = 0; e < 8; ++e) { kb[e] = f2bf(o[rr][e] * 0.08838834764831845f); KT[(jj + e) * 72 + s0 + rr] = (bf16_t)kb[e]; }
                u32x4 w; w.x = kb[0] | (kb[1] << 16); w.y = kb[2] | (kb[3] << 16); w.z = kb[4] | (kb[5] << 16); w.w = kb[6] | (kb[7] << 16);
                *(u32x4*)(kc + (size_t)(t + rr) * 512 + h * 128 + jj) = w; }
#pragma unroll
            for (int rr = 0; rr < 2; ++rr) { const u32x4 w = *(const u32x4*)(proj + (size_t)(t + rr) * NPROJ + 1024 + h * 128 + jj); const float ws = wsrc[s0 + rr];
#pragma unroll
                for (int j = 0; j < 4; ++j) { VT[(jj + 2 * j) * 72 + s0 + rr] = (bf16_t)f2bf(bflo(w[j]) * ws); VT[(jj + 2 * j + 1) * 72 + s0 + rr] = (bf16_t)f2bf(bfhi(w[j]) * ws); } }
        }
        __syncthreads();
        {
            const int fr = F.lane & 15, fq = F.lane >> 4;
            bf16x8 a[2];
#pragma unroll
            for (int ks = 0; ks < 2; ++ks) a[ks] = *(const LAS bf16x8*)(VT + (16 * F.wave + fr) * 72 + 32 * ks + 8 * fq);
            float* cbase = cloc + (size_t)u * 16384;
#pragma unroll
            for (int nt = 0; nt < 8; ++nt) {
                f32x4 acc = (f32x4){0.f, 0.f, 0.f, 0.f};
#pragma unroll
                for (int ks = 0; ks < 2; ++ks) { const bf16x8 bb = *(const LAS bf16x8*)(KT + (16 * nt + fr) * 72 + 32 * ks + 8 * fq); acc = __builtin_amdgcn_mfma_f32_16x16x32_bf16(a[ks], bb, acc, 0, 0, 0); }
#pragma unroll
                for (int rg = 0; rg < 4; ++rg) cbase[(16 * F.wave + 4 * fq + rg) * 128 + 16 * nt + fr] = acc[rg];
            }
            if (F.tid < 128) { float s = 0.f;
#pragma unroll 8
                for (int ss = 0; ss < 64; ++ss) s += wsrc[ss] * bf2f(KT[F.tid * 72 + ss]);
                nloc[(size_t)u * 128 + F.tid] = s; }
        }
        __syncthreads();
    }
}
__device__ __forceinline__ void phase_mlstm_scan(const Ctx& F) {
    const float* mloc = wsp<float>(F, SM_MLOC); const float* blast = wsp<float>(F, SM_BLAST); float* mprev = wsp<float>(F, SM_MPREV);
    const float* cloc = wsp<float>(F, WS_CLOC); const float* nloc = wsp<float>(F, SM_NLOC); bf16_t* cprev = wsp<bf16_t>(F, WS_CPREV);
    const int gt = F.blk * NTHREADS + F.tid, ngt = F.G * NTHREADS;
    for (int i = gt; i < 32 * 4096; i += ngt) {
        const int bh = i >> 12, q = i & 4095, e4 = q * 4;
        f32x4 C = (f32x4){0.f, 0.f, 0.f, 0.f}, nn = (f32x4){0.f, 0.f, 0.f, 0.f}; float m = 0.f;
        for (int c = 0; c < 32; ++c) {
            const int u = bh * 32 + c; bf16_t* cp = cprev + (size_t)u * 144 * 128;
            { u32x2 w; w.x = pk2(C[0], C[1]); w.y = pk2(C[2], C[3]); *(u32x2*)(cp + e4) = w; }
            if (q < 32) { u32x2 w; w.x = pk2(nn[0], nn[1]); w.y = pk2(nn[2], nn[3]); *(u32x2*)(cp + 128 * 128 + 4 * q) = w; }
            else if (q < 32 + 240) { *(u32x4*)(cp + 129 * 128 + (q - 32) * 8) = (u32x4){0u, 0u, 0u, 0u}; }
            if (q == 0) mprev[u] = m;
            const float bl = blast[u], ml = mloc[u];
            const float mn = fmaxf(bl + m, ml), a = __expf(bl + m - mn), cc = __expf(ml - mn);
            C = C * a + *(const f32x4*)(cloc + (size_t)u * 16384 + e4) * cc;
            if (q < 32) nn = nn * a + *(const f32x4*)(nloc + (size_t)u * 128 + 4 * q) * cc;
            m = mn;
        }
    }
}
__device__ __forceinline__ void phase_mlstm_out(const Ctx& F, int l, int first, int stride) {
    const bf16_t* proj = wsp<bf16_t>(F, WS_PROJ); const bf16_t* qc = wsp<bf16_t>(F, WS_QC); const bf16_t* kc = wsp<bf16_t>(F, WS_KC);
    const float* bcum = wsp<float>(F, SM_BCUM); const float* iga = wsp<float>(F, SM_IGA); const float* mprev = wsp<float>(F, SM_MPREV);
    const bf16_t* cprev = wsp<bf16_t>(F, WS_CPREV); bf16_t* mixed = wsp<bf16_t>(F, WS_MIXED); const float* ng = F.in[9] + l * 512;
    LAS bf16_t* VT = (LAS bf16_t*)F.lds;
    LAS bf16_t* PM = (LAS bf16_t*)(F.lds + 20736);
    LAS float* sc = (LAS float*)(F.lds + 20736 + 9216);
    const int fr = F.lane & 15, fq = F.lane >> 4;
    for (int u = first; u < 1024; u += stride) {
        const int bh = u >> 5, c = u & 31, b = bh >> 2, h = bh & 3, t0 = b * SEQ + c * 64;
        if (F.wave == 0) {
            const int t = t0 + F.lane; const float bb = bcum[(size_t)t * 4 + h], ig = iga[(size_t)t * 4 + h], mp = mprev[u];
            const float gqv = ig - bb; float pm = gqv;
#pragma unroll
            for (int o = 1; o < 64; o <<= 1) { const float y = __shfl_up(pm, o); if (F.lane >= o) pm = fmaxf(pm, y); }
            const float mt = bb + fmaxf(mp, pm);
            sc[F.lane] = bb - mt; sc[64 + F.lane] = gqv; sc[128 + F.lane] = __expf(bb + mp - mt); sc[192 + F.lane] = __expf(-mt);
        }
        {
            const int jj = (F.tid & 15) * 8, s0 = (F.tid >> 4) * 2;
#pragma unroll
            for (int rr = 0; rr < 2; ++rr) { const u32x4 w = *(const u32x4*)(proj + (size_t)(t0 + s0 + rr) * NPROJ + 1024 + h * 128 + jj);
#pragma unroll
                for (int j = 0; j < 4; ++j) { VT[(jj + 2 * j) * 72 + s0 + rr] = (bf16_t)(w[j] & 0xffffu); VT[(jj + 2 * j + 1) * 72 + s0 + rr] = (bf16_t)(w[j] >> 16); } }
            for (int i = F.tid; i < 16 * 64; i += NTHREADS) { const int rrow = i >> 6, cc = i & 63; VT[(128 + rrow) * 72 + cc] = rrow == 0 ? (bf16_t)0x3F80 : (bf16_t)0; }
        }
        __syncthreads();
        const int tt = F.wave & 3, hf = F.wave >> 2;
        bf16x8 qa[4];
#pragma unroll
        for (int ks = 0; ks < 4; ++ks) qa[ks] = *(const bf16x8*)(qc + (size_t)(t0 + 16 * tt + fr) * 512 + h * 128 + 32 * ks + 8 * fq);
        {
            const int trow = 16 * tt + fr; const float re = sc[trow];
#pragma unroll
            for (int si = 0; si < 2; ++si) { const int st = 2 * hf + si; f32x4 acc = (f32x4){0.f, 0.f, 0.f, 0.f};
#pragma unroll
                for (int ks = 0; ks < 4; ++ks) { const bf16x8 kb = *(const bf16x8*)(kc + (size_t)(t0 + 16 * st + fr) * 512 + h * 128 + 32 * ks + 8 * fq);
                    acc = __builtin_amdgcn_mfma_f32_16x16x32_bf16(kb, qa[ks], acc, 0, 0, 0); }
                float pv[4];
#pragma unroll
                for (int j = 0; j < 4; ++j) { const int s = 16 * st + 4 * fq + j; const float e = __expf(re + sc[64 + s]); pv[j] = (s <= trow) ? acc[j] * e : 0.f; }
                u32x2 w; w.x = pk2(pv[0], pv[1]); w.y = pk2(pv[2], pv[3]); *(LAS u32x2*)(PM + trow * 72 + 16 * st + 4 * fq) = w; }
        }
        __syncthreads();
        {
            const int trow = 16 * tt + fr, t = t0 + trow; const float wi = sc[128 + trow], enm = sc[192 + trow];
            bf16x8 pa[2];
#pragma unroll
            for (int ks = 0; ks < 2; ++ks) pa[ks] = *(const LAS bf16x8*)(PM + trow * 72 + 32 * ks + 8 * fq);
            const bf16_t* cp = cprev + (size_t)u * 144 * 128;
            f32x4 num[5];
#pragma unroll
            for (int ci = 0; ci < 5; ++ci) { const int ct = ci < 4 ? 4 * hf + ci : 8;
                f32x4 apv = (f32x4){0.f, 0.f, 0.f, 0.f}, ain = (f32x4){0.f, 0.f, 0.f, 0.f};
#pragma unroll
                for (int ks = 0; ks < 2; ++ks) { const bf16x8 vb = *(const LAS bf16x8*)(VT + (16 * ct + fr) * 72 + 32 * ks + 8 * fq); apv = __builtin_amdgcn_mfma_f32_16x16x32_bf16(vb, pa[ks], apv, 0, 0, 0); }
#pragma unroll
                for (int ks = 0; ks < 4; ++ks) { const bf16x8 cb = *(const bf16x8*)(cp + (size_t)(16 * ct + fr) * 128 + 32 * ks + 8 * fq); ain = __builtin_amdgcn_mfma_f32_16x16x32_bf16(cb, qa[ks], ain, 0, 0, 0); }
                num[ci] = apv + ain * wi; }
            const float den = __shfl(num[4][0], fr);
            const float dn = 1.0f / fmaxf(fabsf(den), enm);
            float s1 = 0.f;
#pragma unroll
            for (int ci = 0; ci < 4; ++ci) { num[ci] = num[ci] * dn; s1 += (num[ci][0] + num[ci][1]) + (num[ci][2] + num[ci][3]); }
            s1 += __shfl_xor(s1, 16); s1 += __shfl_xor(s1, 32);
            if (fq == 0) sc[256 + trow * 2 + hf] = s1;
            __syncthreads();
            const float mean = (sc[256 + trow * 2] + sc[256 + trow * 2 + 1]) * (1.0f / 128.0f);
            float s2 = 0.f;
#pragma unroll
            for (int ci = 0; ci < 4; ++ci) { num[ci] = num[ci] - mean; s2 += (num[ci][0] * num[ci][0] + num[ci][1] * num[ci][1]) + (num[ci][2] * num[ci][2] + num[ci][3] * num[ci][3]); }
            s2 += __shfl_xor(s2, 16); s2 += __shfl_xor(s2, 32);
            if (fq == 0) sc[384 + trow * 2 + hf] = s2;
            __syncthreads();
            const float rstd = 1.0f / sqrtf((sc[384 + trow * 2] + sc[384 + trow * 2 + 1]) * (1.0f / 128.0f) + 1e-5f);
#pragma unroll
            for (int ci = 0; ci < 4; ++ci) { const int col = h * 128 + 16 * (4 * hf + ci) + 4 * fq;
                const u32x2 mo = *(const u32x2*)(proj + (size_t)t * NPROJ + 1536 + col); const f32x4 gg = *(const f32x4*)(ng + col);
                const float o0 = num[ci][0] * rstd * gg[0] * sigmoidf_(bflo(mo.x)), o1 = num[ci][1] * rstd * gg[1] * sigmoidf_(bfhi(mo.x));
                const float o2 = num[ci][2] * rstd * gg[2] * sigmoidf_(bflo(mo.y)), o3 = num[ci][3] * rstd * gg[3] * sigmoidf_(bfhi(mo.y));
                u32x2 w; w.x = pk2(o0, o1); w.y = pk2(o2, o3); *(u32x2*)(mixed + (size_t)t * DM + col) = w; }
        }
        __syncthreads();
    }
}

__device__ __forceinline__ void phase_router(const Ctx& F, int l) {
    LAS float* W = (LAS float*)F.lds;
    LAS float* lg = (LAS float*)(F.lds + MISC_OFF);
    LAS unsigned* hist = (LAS unsigned*)(F.lds + MISC_OFF + 2048);
    const float* wr = F.in[29] + (size_t)l * 1024 * 32; const float* br = F.in[30] + l * 32;
    const float* H = wsp<float>(F, WS_H); int* topi = wsp<int>(F, SM_TOPI); float* topg = wsp<float>(F, SM_TOPG); unsigned* ctl = wsp<unsigned>(F, WS_CTL);
    for (int i = F.tid; i < 8192; i += NTHREADS) ((LAS f32x4*)W)[i] = ((const f32x4*)wr)[i];
    if (F.tid < 32) hist[F.tid] = 0u;
    __syncthreads();
    const int r = F.tid >> 5, e = F.tid & 31;
    for (int base = F.blk * 16; base < T_TOK; base += F.G * 16) {
        const int t = base + r; const float* hr = H + (size_t)t * DM;
        float a0 = br[e], a1 = 0.f, a2 = 0.f, a3 = 0.f;
#pragma unroll 4
        for (int d4 = 0; d4 < 256; ++d4) { const f32x4 hv = *(const f32x4*)(hr + 4 * d4); const LAS float* wp = W + (4 * d4) * 32 + e;
            a0 += hv[0] * wp[0]; a1 += hv[1] * wp[32]; a2 += hv[2] * wp[64]; a3 += hv[3] * wp[96]; }
        lg[r * 32 + e] = (a0 + a1) + (a2 + a3);
        __syncthreads();
        if (e == 0) {
            float v[4]; int id[4]; unsigned used = 0u;
#pragma unroll
            for (int k = 0; k < 4; ++k) { float best = -3.0e38f; int bi = 0;
                for (int j = 0; j < 32; ++j) { const float x = lg[r * 32 + j]; if (!((used >> j) & 1u) && x > best) { best = x; bi = j; } }
                used |= 1u << bi; v[k] = best; id[k] = bi; }
            const float e1 = __expf(v[1] - v[0]), e2 = __expf(v[2] - v[0]), e3 = __expf(v[3] - v[0]); const float inv = 1.0f / (1.0f + e1 + e2 + e3);
            topi[t * 4 + 0] = id[0]; topi[t * 4 + 1] = id[1]; topi[t * 4 + 2] = id[2]; topi[t * 4 + 3] = id[3];
            topg[t * 4 + 0] = inv; topg[t * 4 + 1] = e1 * inv; topg[t * 4 + 2] = e2 * inv; topg[t * 4 + 3] = e3 * inv;
#pragma unroll
            for (int k = 0; k < 4; ++k) atomicAdd((unsigned*)&hist[id[k]], 1u);
        }
        __syncthreads();
    }
    if (F.tid < 32 && hist[F.tid]) atomicAdd(&ctl[CW_CNT + l * 32 + F.tid], hist[F.tid]);
}
__device__ __forceinline__ void phase_slots(const Ctx& F, int l) {
    LAS unsigned* lc = (LAS unsigned*)F.lds; LAS unsigned* lbase = lc + 32; LAS unsigned* pst = lc + 64; LAS int* aslot = (LAS int*)(lc + 128); LAS int* atok = aslot + 256;
    unsigned* ctl = wsp<unsigned>(F, WS_CTL); const int* topi = wsp<int>(F, SM_TOPI); int* slotp = wsp<int>(F, SM_SLOT);
    const bf16_t* HB = wsp<bf16_t>(F, WS_HB); bf16_t* XG = wsp<bf16_t>(F, WS_XG);
    if (F.tid < 32) lc[F.tid] = 0u;
    if (F.tid == 0) { unsigned acc = 0u;
        for (int e = 0; e < 32; ++e) { pst[e] = acc; const unsigned c = ctl[CW_CNT + l * 32 + e]; acc += ((c + 255u) >> 8) << 8; }
        pst[32] = acc;
        if (F.blk == 0) for (int e = 0; e <= 32; ++e) ctl[CW_TILE + l * 40 + e] = pst[e] >> 8; }
    __syncthreads();
    for (int tb = F.blk; tb < T_TOK / 64; tb += F.G) {
        int myE = 0, myRank = 0, t = 0, k = 0;
        if (F.tid < 256) { t = tb * 64 + (F.tid >> 2); k = F.tid & 3; myE = topi[t * 4 + k]; myRank = (int)atomicAdd((unsigned*)&lc[myE], 1u); }
        __syncthreads();
        if (F.tid < 32) lbase[F.tid] = lc[F.tid] ? atomicAdd(&ctl[CW_CUR + l * 32 + F.tid], lc[F.tid]) : 0u;
        __syncthreads();
        if (F.tid < 256) { const int sl = (int)(pst[myE] + lbase[myE]) + myRank; slotp[t * 4 + k] = sl; aslot[F.tid] = sl; atok[F.tid] = t; }
        __syncthreads();
        if (F.tid < 32) lc[F.tid] = 0u;
        for (int a = 0; a < 32; ++a) { const int idx = F.wave * 32 + a; const int sl = aslot[idx], tk = atok[idx];
            const u32x4* src = (const u32x4*)(HB + (size_t)tk * DM); u32x4* dst = (u32x4*)(XG + (size_t)sl * DM);
            dst[F.lane] = src[F.lane]; dst[64 + F.lane] = src[64 + F.lane]; }
        __syncthreads();
    }
}

__device__ __forceinline__ const void* launder(const void* p) {
    unsigned long long x = (unsigned long long)p; unsigned lo = (unsigned)x, hi = (unsigned)(x >> 32);
    asm volatile("" : "+v"(lo), "+v"(hi));
    lo = __builtin_amdgcn_readfirstlane(lo); hi = __builtin_amdgcn_readfirstlane(hi);
    return (const void*)(((unsigned long long)hi << 32) | lo);
}
__device__ __forceinline__ void moe_build_units(const Ctx& F, int l, int npn) {
    LAS int* ul = (LAS int*)(F.lds + MISC_OFF + 4096);
    const unsigned* ts = wsp<unsigned>(F, WS_CTL) + CW_TILE + l * 40;
    if (F.tid < 16) {
        const int NT = (int)ts[32]; const long L = (long)F.tid * F.G + F.blk; int pm = -1, pn = 0, e = 0;
        if (L < (long)NT * npn) { pm = (int)(L / npn); pn = (int)(L % npn); for (int j = 1; j < 32; ++j) e += ((int)ts[j] <= pm) ? 1 : 0; }
        ul[3 * F.tid] = pm; ul[3 * F.tid + 1] = pn; ul[3 * F.tid + 2] = e;
    }
    __syncthreads();
}

#define XB_TMO      128
#define XB_XCNT(j)  (256  + 64 * (j))
#define XB_XSUB(j)  (1280 + 64 * (j))
#define XB_XGEN(j)  (2304 + 64 * (j))
#define XB_TOP      3328
#define XB_TOPGEN   3392
#define XCD_BAR_WORDS 3456
#define XB_SPIN_CAP (1u << 22)
constexpr int CW_BAR = 1024;
__device__ __forceinline__ unsigned xb_ld(unsigned* p)              { return __hip_atomic_load(p, __ATOMIC_RELAXED, __HIP_MEMORY_SCOPE_AGENT); }
__device__ __forceinline__ unsigned xb_add(unsigned* p, unsigned v) { return __hip_atomic_fetch_add(p, v, __ATOMIC_RELAXED, __HIP_MEMORY_SCOPE_AGENT); }
__device__ __forceinline__ unsigned xb_xcc_id() { return (unsigned)__builtin_amdgcn_s_getreg((3 << 11) | 20) & 0xFu; }
#define XB_SPIN(cond, bar) do { unsigned _sp = 0; while (cond) { __builtin_amdgcn_s_sleep(1); \
    if ((++_sp & 255u) == 0u) { if (xb_ld(&(bar)[XB_TMO])) break; if (_sp > XB_SPIN_CAP) { atomicAdd(&(bar)[XB_TMO], 1u); break; } } } } while (0)
struct XcdBarrier { unsigned* bar; unsigned x; volatile LAS unsigned* st; };
__device__ __forceinline__ XcdBarrier xcd_barrier_post(unsigned* bar, volatile LAS unsigned* st) {
    XcdBarrier b; b.bar = bar; b.x = xb_xcc_id(); b.st = st;
    if (threadIdx.x == 0) (void)xb_add(&bar[XB_XCNT(b.x)], 1u);
    return b;
}
__device__ __forceinline__ void xcd_barrier_complete(unsigned* bar, unsigned x, unsigned& nloc, unsigned& nx) {
    const unsigned G = gridDim.x * gridDim.y * gridDim.z;
    unsigned sum, cnt, mine, sp = 0u;
    for (;;) {
        sum = 0u; cnt = 0u; mine = 0u;
#pragma unroll
        for (unsigned j = 0; j < 16; ++j) { const unsigned c = xb_ld(&bar[XB_XCNT(j)]); sum += c; cnt += (c > 0u) ? 1u : 0u; mine = (j == x) ? c : mine; }
        if (sum == G) break;
        __builtin_amdgcn_s_sleep(1);
        if ((++sp & 255u) == 0u) { if (xb_ld(&bar[XB_TMO])) break; if (sp > XB_SPIN_CAP) { atomicAdd(&bar[XB_TMO], 1u); break; } }
    }
    nloc = mine > 0u ? mine : 1u; nx = cnt > 0u ? cnt : 1u;
}
__device__ __forceinline__ void xcd_barrier(const XcdBarrier& b) {
    asm volatile("s_waitcnt vmcnt(0)" ::: "memory");
    __syncthreads();
    if (threadIdx.x == 0) {
        unsigned* bar = b.bar;
        __builtin_amdgcn_s_waitcnt(0);
        unsigned nloc = b.st[0], nx = b.st[1];
        if (nloc == 0u) { xcd_barrier_complete(bar, b.x, nloc, nx); b.st[0] = nloc; b.st[1] = nx; }
        const unsigned old = xb_add(&bar[XB_XSUB(b.x)], 1u);
        const unsigned gen = old / nloc;
        if (old + 1u == (gen + 1u) * nloc) {
            __builtin_amdgcn_fence(__ATOMIC_RELEASE, "agent");
            asm volatile("s_waitcnt vmcnt(0)" ::: "memory");
            const unsigned og = xb_add(&bar[XB_TOP], 1u);
            const unsigned tg = og / nx;
            if (og + 1u == (tg + 1u) * nx) xb_add(&bar[XB_TOPGEN], 1u);
            else XB_SPIN(xb_ld(&bar[XB_TOPGEN]) == tg, bar);
            __builtin_amdgcn_fence(__ATOMIC_ACQUIRE, "agent");
            xb_add(&bar[XB_XGEN(b.x)], 1u);
            asm volatile("s_waitcnt vmcnt(0)" ::: "memory");
        } else {
            XB_SPIN(xb_ld(&bar[XB_XGEN(b.x)]) == gen, bar);
            __builtin_amdgcn_fence(__ATOMIC_ACQUIRE, "agent");
            asm volatile("s_waitcnt vmcnt(0)" ::: "memory");
        }
    }
    __syncthreads();
}
constexpr int PH_PER_LAYER = 18, NPHASES = 2 + DEPTH * PH_PER_LAYER;
__global__ void __launch_bounds__(NTHREADS, 2) mk_fwd(Args args) {
    extern __shared__ __attribute__((aligned(16))) unsigned char lds_raw[];
    Ctx F; F.lds = (LAS unsigned char*)lds_raw; F.tid = threadIdx.x; F.lane = F.tid & 63; F.wave = __builtin_amdgcn_readfirstlane(F.tid >> 6);
    F.blk = blockIdx.x; F.G = gridDim.x; F.gw = F.blk * NWAVES + F.wave; F.ngw = F.G * NWAVES;
    {   LAS unsigned long long* tab = (LAS unsigned long long*)(F.lds + TAB_OFF);
        if (F.tid == 0) {
#define TB_(k) tab[k] = (unsigned long long)args.in[k];
            TB_(0) TB_(1) TB_(2) TB_(3) TB_(4) TB_(5) TB_(6) TB_(7) TB_(8) TB_(9) TB_(10) TB_(11) TB_(12) TB_(13) TB_(14) TB_(15) TB_(16) TB_(17) TB_(18)
            TB_(19) TB_(20) TB_(21) TB_(22) TB_(23) TB_(24) TB_(25) TB_(26) TB_(27) TB_(28) TB_(29) TB_(30) TB_(31) TB_(32) TB_(33) TB_(34) TB_(35) TB_(36)
#undef TB_
            tab[37] = (unsigned long long)args.out; tab[38] = (unsigned long long)args.ws;
            ((LAS unsigned*)(F.lds + TAB_OFF + 512))[0] = 0u; ((LAS unsigned*)(F.lds + TAB_OFF + 512))[1] = 0u; }
        __syncthreads();
        F.in.t = (LAS const volatile unsigned*)(F.lds + TAB_OFF); F.out = nullptr; F.ws = nullptr; }
    const int lo = args.ph_lo, hi = args.ph_hi;
    XcdBarrier xbar = xcd_barrier_post((unsigned*)(args.ws + WS_CTL) + CW_BAR, (volatile LAS unsigned*)(F.lds + TAB_OFF + 512));
#if ONE_LAUNCH
    cg::grid_group grid = cg::this_grid();
#define SEAM(k) do { if ((k) + 1 < hi) { if ((k) == 0) grid.sync(); else xcd_barrier(xbar); } } while (0)
#else
#define SEAM(k) do { } while (0)
#endif
#ifndef PHMASK
#define PHMASK 0xFFFFFu
#endif
#define IN(k) (lo <= (k) && (k) < hi)
#define ON(r) (((PHMASK) >> (r)) & 1u)
#define REPEAT(r) for (int rep_ = 0; rep_ < (((r) == PROBE_PH) ? 1 + PROBE_N : 1); ++rep_)
#define FRESH() do { int _t = threadIdx.x; int _b = blockIdx.x, _g = gridDim.x; unsigned _l = (unsigned)(uintptr_t)(LAS unsigned char*)lds_raw; asm volatile("" : "+v"(_t), "+s"(_b), "+s"(_g), "+s"(_l)); F.tid = _t; F.lane = _t & 63; F.wave = __builtin_amdgcn_readfirstlane(_t >> 6); F.blk = _b; F.G = _g; F.gw = _b * NWAVES + F.wave; F.ngw = _g * NWAVES; F.lds = (LAS unsigned char*)(uintptr_t)_l; lds = F.lds; F.in.t = (LAS const volatile unsigned*)(F.lds + TAB_OFF); F.out = (float*)F.in.get(37); F.ws = (unsigned char*)F.in.get(38); } while (0)
    LAS unsigned char* lds = F.lds;
    if (ON(18) && IN(0)) { FRESH(); REPEAT(18) { phase_prologue(F); __syncthreads(); __syncthreads(); } SEAM(0); }
    if (ON(19) && IN(1)) { FRESH(); REPEAT(19) {
        pg8::KvOrder S; S.memb = (const char*)wsp<bf16_t>(F, WS_MEMB); S.wkv = (const char*)wsp<bf16_t>(F, WS_WKV); S.lda = 1024; S.ldb = 1024; S.K = 1024; S.G = F.G; S.c = F.blk;
        pg8::EpiKv E{wsp<bf16_t>(F, WS_KBUF), wsp<bf16_t>(F, WS_VTB)};
        pg8::gemm_phase(lds, S, E); __syncthreads(); __syncthreads(); } SEAM(1);
    }
    for (int l = 0; l < DEPTH; ++l) {
        const int pb = 2 + l * PH_PER_LAYER;
        if (ON(0) && IN(pb + 0)) { FRESH(); REPEAT(0) {
            pg8::DenseOrder S; S.init(wsp<bf16_t>(F, WS_HB), wsp<bf16_t>(F, WS_WIN) + (size_t)l * 4096 * 1024, T_TOK, NPROJ, 1024, 1024, 1024, F.G, F.blk);
            pg8::EpiProj E{wsp<bf16_t>(F, WS_PROJ), wsp<float>(F, SM_GATES)};
            pg8::gemm_phase(lds, S, E); __syncthreads(); __syncthreads(); } SEAM(pb + 0);
        }
        if (ON(1) && IN(pb + 1)) { FRESH(); REPEAT(1) { phase_xlr(F, l); phase_mlstm_prep(F, l); __syncthreads(); __syncthreads(); } SEAM(pb + 1); }
        if (ON(2) && IN(pb + 2)) { FRESH(); REPEAT(2) {
            pg8::DenseOrder S; S.init(wsp<bf16_t>(F, WS_XLR), wsp<bf16_t>(F, WS_WLR) + (size_t)l * 1536 * 256, T_TOK, 1536, 256, 256, 256, F.G, F.blk);
            pg8::EpiF32 E{wsp<float>(F, WS_LR), 1536};
            pg8::gemm_phase(lds, S, E); __syncthreads();
            phase_mlstm_scan(F); __syncthreads(); } SEAM(pb + 2);
        }
        if (ON(3) && IN(pb + 3)) { FRESH(); REPEAT(3) { phase_rwkv_prep(F, l); __syncthreads(); } SEAM(pb + 3); }
        if (ON(4) && IN(pb + 4)) { FRESH(); REPEAT(4) { if (F.blk < 128) phase_rwkv_scan(F); else phase_mlstm_out(F, l, F.blk - 128, F.G - 128); __syncthreads(); __syncthreads(); } SEAM(pb + 4); }
        if (ON(5) && IN(pb + 5)) { FRESH(); REPEAT(5) { phase_rwkv_post(F, l); __syncthreads(); } SEAM(pb + 5); }
        if (ON(6) && IN(pb + 6)) { FRESH(); REPEAT(6) {
            pg8::DenseOrder S; S.init(wsp<bf16_t>(F, WS_MIXED), wsp<bf16_t>(F, WS_WOUT) + (size_t)l * 1024 * 1024, T_TOK, 1024, 1024, 1024, 1024, F.G, F.blk);
            pg8::EpiF32 E{wsp<float>(F, WS_CF), 1024};
            pg8::gemm_phase(lds, S, E); __syncthreads(); __syncthreads(); } SEAM(pb + 6);
        }
        if (ON(7) && IN(pb + 7)) { FRESH(); REPEAT(7) { phase_ln_add(F, F.in[22] + l * 1024, F.in[23] + l * 1024); __syncthreads(); } SEAM(pb + 7); }
        if (ON(8) && IN(pb + 8)) { FRESH(); REPEAT(8) {
            pg8::DenseOrder S; S.init(wsp<bf16_t>(F, WS_HB), wsp<bf16_t>(F, WS_WQ) + (size_t)l * 1024 * 1024, T_TOK, 1024, 1024, 1024, 1024, F.G, F.blk);
            pg8::EpiBf16 E{wsp<bf16_t>(F, WS_QB), 1024, 0.0625f};
            pg8::gemm_phase(lds, S, E); __syncthreads(); __syncthreads(); } SEAM(pb + 8);
        }
        if (ON(9) && IN(pb + 9)) { FRESH(); REPEAT(9) {
            pg8::SOrder S; S.Q = (const char*)wsp<bf16_t>(F, WS_QB); S.Kb = (const char*)(wsp<bf16_t>(F, WS_KBUF) + (size_t)l * 2048 * 1024); S.lda = 1024; S.ldb = 1024; S.K = 256; S.G = F.G; S.c = F.blk;
            pg8::EpiSoftmax E{wsp<bf16_t>(F, WS_PB)};
            pg8::gemm_phase(lds, S, E); __syncthreads(); __syncthreads(); } SEAM(pb + 9);
        }
        if (ON(10) && IN(pb + 10)) { FRESH(); REPEAT(10) {
            pg8::PvOrder S; S.P = (const char*)wsp<bf16_t>(F, WS_PB); S.Vt = (const char*)(wsp<bf16_t>(F, WS_VTB) + (size_t)l * 1024 * 2048); S.lda = 256; S.ldb = 2048; S.K = 256; S.G = F.G; S.c = F.blk;
            pg8::EpiPv E{wsp<bf16_t>(F, WS_OB)};
            pg8::gemm_phase(lds, S, E); __syncthreads(); __syncthreads(); } SEAM(pb + 10);
        }
        if (ON(11) && IN(pb + 11)) { FRESH(); REPEAT(11) {
            pg8::DenseOrder S; S.init(wsp<bf16_t>(F, WS_OB), wsp<bf16_t>(F, WS_WO) + (size_t)l * 1024 * 1024, T_TOK, 1024, 1024, 1024, 1024, F.G, F.blk);
            pg8::EpiF32 E{wsp<float>(F, WS_CF), 1024};
            pg8::gemm_phase(lds, S, E); __syncthreads(); __syncthreads(); } SEAM(pb + 11);
        }
        if (ON(12) && IN(pb + 12)) { FRESH(); REPEAT(12) { phase_ln_add(F, F.in[27] + l * 1024, F.in[28] + l * 1024); __syncthreads(); } SEAM(pb + 12); }
        if (ON(13) && IN(pb + 13)) { FRESH(); REPEAT(13) { phase_router(F, l); __syncthreads(); __syncthreads(); } SEAM(pb + 13); }
        if (ON(14) && IN(pb + 14)) { FRESH(); REPEAT(14) { phase_slots(F, l); __syncthreads(); __syncthreads(); } SEAM(pb + 14); }
        if (ON(15) && IN(pb + 15)) { FRESH(); REPEAT(15) {
            moe_build_units(F, l, 8);
            pg8::MoeOrder S; S.A = (const char*)wsp<bf16_t>(F, WS_XG); S.W = (const char*)(wsp<bf16_t>(F, WS_W1) + (size_t)l * 32 * 2048 * 1024); S.ul = (LAS const int*)(F.lds + MISC_OFF + 4096);
            S.wstride = (size_t)2048 * 1024 * 2; S.lda = 1024; S.ldb = 1024; S.K = 1024;
            pg8::EpiSwiglu E{wsp<bf16_t>(F, WS_GACT), F.in[32] + (size_t)l * 32 * 2048};
            pg8::gemm_phase(lds, S, E); __syncthreads(); __syncthreads(); } SEAM(pb + 15);
        }
        if (ON(16) && IN(pb + 16)) { FRESH(); REPEAT(16) {
            moe_build_units(F, l, 4);
            pg8::MoeOrder S; S.A = (const char*)wsp<bf16_t>(F, WS_GACT); S.W = (const char*)(wsp<bf16_t>(F, WS_W2) + (size_t)l * 32 * 1024 * 1024); S.ul = (LAS const int*)(F.lds + MISC_OFF + 4096);
            S.wstride = (size_t)1024 * 1024 * 2; S.lda = 1024; S.ldb = 1024; S.K = 1024;
            pg8::EpiMoeY E{wsp<bf16_t>(F, WS_YB), F.in[34] + (size_t)l * 32 * 1024};
            pg8::gemm_phase(lds, S, E); __syncthreads(); __syncthreads(); } SEAM(pb + 16);
        }
        if (ON(17) && IN(pb + 17)) { FRESH(); REPEAT(17) { phase_ln_moe(F, F.in[35] + l * 1024, F.in[36] + l * 1024, l == DEPTH - 1); __syncthreads(); } SEAM(pb + 17); }
    }
#undef IN
#undef SEAM
}

extern "C" void kernel_launch(void* const* d_in, const int* in_sizes, int n_in, void* d_out, int out_size, void* d_ws, size_t ws_size, hipStream_t stream) {
    static int grid = 0;
    if (grid == 0) {
        if (n_in != 37 || out_size != T_TOK * DM || ws_size < WS_END) { fprintf(stderr, "kernel_launch: unexpected shapes: n_in %d out %d ws %zu (need %zu)\n", n_in, out_size, ws_size, (size_t)WS_END); grid = -1; return; }
        int dev = 0, cus = 0, per_cu = 0;
        hipGetDevice(&dev); hipDeviceGetAttribute(&cus, hipDeviceAttributeMultiprocessorCount, dev);
        if (hipFuncSetAttribute((const void*)mk_fwd, hipFuncAttributeMaxDynamicSharedMemorySize, LDS_BYTES) != hipSuccess) { fprintf(stderr, "kernel_launch: hipFuncSetAttribute failed\n"); grid = -1; return; }
        if (hipOccupancyMaxActiveBlocksPerMultiprocessor(&per_cu, (const void*)mk_fwd, NTHREADS, LDS_BYTES) != hipSuccess || per_cu < 1) { fprintf(stderr, "kernel_launch: occupancy query says %d blocks per CU\n", per_cu); (void)hipGetLastError(); per_cu = 1; }
        grid = cus;
        if (grid > 256) grid = 256;
    }
    if (grid < 0) return;
    (void)hipMemsetAsync((char*)d_ws + WS_CTL, 0, CTL_BYTES, stream);
    Args a{};
    for (int i = 0; i < 37; ++i) a.in[i] = (const float*)d_in[i];
    a.out = (float*)d_out; a.ws = (unsigned char*)d_ws;
#if ONE_LAUNCH
    a.ph_lo = 0; a.ph_hi = NPHASES;
    void* kargs[] = {&a};
    hipError_t e = hipLaunchCooperativeKernel((const void*)mk_fwd, dim3(grid), dim3(NTHREADS), kargs, LDS_BYTES, stream);
    if (e != hipSuccess) fprintf(stderr, "kernel_launch: cooperative launch failed: %s (grid %d)\n", hipGetErrorString(e), grid);
#else
    for (int ph = 0; ph < NPHASES; ++ph) { a.ph_lo = ph; a.ph_hi = ph + 1; hipLaunchKernelGGL(mk_fwd, dim3(grid), dim3(NTHREADS), LDS_BYTES, stream, a); }
#endif
}
```

```cpp
#include <hip/hip_runtime.h>
#include <hip/hip_cooperative_groups.h>
#include <cstdio>
#include <cstdint>
namespace cg = cooperative_groups;

#ifndef PROBE_PH
#define PROBE_PH -1
#endif
#ifndef PROBE_SUB
#define PROBE_SUB 0
#endif
#ifndef PROBE_N
#define PROBE_N 0
#endif
#ifndef ONE_LAUNCH
#define ONE_LAUNCH 1
#endif

#define LAS __attribute__((address_space(3)))
typedef unsigned short bf16_t;
typedef short bf16x8 __attribute__((ext_vector_type(8)));
typedef float f32x4 __attribute__((ext_vector_type(4)));
typedef float f32x2 __attribute__((ext_vector_type(2)));
typedef unsigned u32x4 __attribute__((ext_vector_type(4)));
typedef unsigned u32x2 __attribute__((ext_vector_type(2)));

constexpr int T_TOK = 16384, DM = 1024, SEQ = 2048, NBATCH = 8, DEPTH = 2;
constexpr int IN_COLS = 3848, NPROJ = 4096;
constexpr int RC0 = 2048;
constexpr int NEXP = 32, NMEM = 256;
constexpr int MOE_ROWS = 65536 + NEXP * 256;
constexpr int RECF = 388;
constexpr float DN_ALPHA = 1.4142135623730951f;
constexpr int NTHREADS = 512, NWAVES = 8;
constexpr int LDS_BYTES = 147456;
constexpr int GEMM_LDS = 131072;
constexpr int MISC_OFF = GEMM_LDS;

constexpr size_t MiB = 1u << 20;
constexpr size_t WS_CTL = 0;
constexpr size_t CTL_BYTES = 65536;
constexpr size_t WS_WIN = 1 * MiB;
constexpr size_t WS_WOUT = WS_WIN + 16 * MiB;
constexpr size_t WS_WQ = WS_WOUT + 4 * MiB;
constexpr size_t WS_WKV = WS_WQ + 4 * MiB;
constexpr size_t WS_WO = WS_WKV + 8 * MiB;
constexpr size_t WS_WLR = WS_WO + 4 * MiB;
constexpr size_t WS_W1 = WS_WLR + 2 * MiB;
constexpr size_t WS_W2 = WS_W1 + 256 * MiB;
constexpr size_t WS_H = WS_W2 + 128 * MiB;
constexpr size_t WS_HB = WS_H + 64 * MiB;
constexpr size_t WS_MEMB = WS_HB + 32 * MiB;
constexpr size_t WS_KBUF = WS_MEMB + 4 * MiB;
constexpr size_t WS_VTB = WS_KBUF + 8 * MiB;
constexpr size_t WS_CF = WS_VTB + 8 * MiB;
constexpr size_t WS_MIXED = WS_CF + 64 * MiB;
constexpr size_t WS_QB = WS_MIXED + 32 * MiB;
constexpr size_t WS_PB = WS_QB + 32 * MiB;
constexpr size_t WS_OB = WS_PB + 32 * MiB;
constexpr size_t WS_SMALL = WS_OB + 32 * MiB;
constexpr size_t SM_GATES = WS_SMALL;
constexpr size_t SM_BCUM = SM_GATES + 512 * 1024;
constexpr size_t SM_IGA = SM_BCUM + 256 * 1024;
constexpr size_t SM_BON = SM_IGA + 256 * 1024;
constexpr size_t SM_TOPI = SM_BON + 512 * 1024;
constexpr size_t SM_TOPG = SM_TOPI + 256 * 1024;
constexpr size_t SM_SLOT = SM_TOPG + 256 * 1024;
constexpr size_t SM_MLOC = SM_SLOT + 256 * 1024;
constexpr size_t SM_BLAST = SM_MLOC + 4096;
constexpr size_t SM_MPREV = SM_BLAST + 4096;
constexpr size_t SM_NLOC = SM_MPREV + 4096;
constexpr size_t WS_UNION = WS_SMALL + 8 * MiB;
constexpr size_t WS_PROJ = WS_UNION;
constexpr size_t WS_XLR = WS_PROJ + 128 * MiB;
constexpr size_t WS_LR = WS_XLR + 8 * MiB;
constexpr size_t WS_REC = WS_LR + 96 * MiB;
constexpr size_t WS_GV = WS_REC + 196 * MiB;
constexpr size_t WS_YR = WS_GV + 32 * MiB;
constexpr size_t WS_QC = WS_YR + 32 * MiB;
constexpr size_t WS_KC = WS_QC + 16 * MiB;
constexpr size_t WS_CLOC = WS_KC + 16 * MiB;
constexpr size_t WS_CPREV = WS_CLOC + 64 * MiB;
constexpr size_t WS_MIXEND = WS_CPREV + 36 * MiB;
constexpr size_t WS_XG = WS_UNION;
constexpr size_t WS_GACT = WS_XG + 144 * MiB;
constexpr size_t WS_YB = WS_GACT + 144 * MiB;
constexpr size_t WS_END = WS_MIXEND;
static_assert(WS_YB + 144 * MiB <= WS_MIXEND, "moe overlay fits");
static_assert((size_t)64 * 2048 * RECF * 4 <= 196 * MiB, "rec fits");
constexpr int CW_CNT = 0;
constexpr int CW_CUR = 64;
constexpr int CW_TILE = 128;

__device__ __forceinline__ unsigned f2bf(float f) { unsigned u = __builtin_bit_cast(unsigned, f); return (u + 0x7fffu + ((u >> 16) & 1u)) >> 16; }
__device__ __forceinline__ unsigned pk2(float lo, float hi) { return f2bf(lo) | (f2bf(hi) << 16); }
__device__ __forceinline__ float bf2f(unsigned b) { return __builtin_bit_cast(float, b << 16); }
__device__ __forceinline__ float bflo(unsigned w) { return __builtin_bit_cast(float, w << 16); }
__device__ __forceinline__ float bfhi(unsigned w) { return __builtin_bit_cast(float, w & 0xffff0000u); }
__device__ __forceinline__ unsigned cvt_pk_bf16(float lo, float hi) { unsigned r; asm volatile("v_cvt_pk_bf16_f32 %0, %1, %2" : "=v"(r) : "v"(lo), "v"(hi)); return r; }
__device__ __forceinline__ float wave_sum(float v) {
#pragma unroll
    for (int o = 1; o < 64; o <<= 1) v += __shfl_xor(v, o);
    return v;
}
__device__ __forceinline__ float wave_max(float v) {
#pragma unroll
    for (int o = 1; o < 64; o <<= 1) v = fmaxf(v, __shfl_xor(v, o));
    return v;
}
__device__ __forceinline__ float sigmoidf_(float x) { return 1.0f / (1.0f + __expf(-x)); }
__device__ __forceinline__ float softplusf_(float x) { return fmaxf(x, 0.f) + log1pf(__expf(-fabsf(x))); }
#define LDS_WAIT() asm volatile("s_waitcnt lgkmcnt(0)" ::: "memory")

namespace pg8 {
constexpr int BM = 256, BK = 64, HALF = 128, HTB = HALF * BK * 2, NXCD = 8, WGM = 8;
__device__ __forceinline__ int lds_byte(int r, int c) { const int st = (r >> 4) * 2 + (c >> 5), rr = r & 15, cc = c & 31, ob = rr * 64 + cc * 2; return st * 1024 + (ob ^ (((ob >> 9) & 1) << 5)); }
__device__ __forceinline__ void stage_rc(int b, int& R, int& C) { const int st = b / 1024, sb = b % 1024, swz = sb ^ (((sb >> 9) & 1) << 5); R = (st >> 1) * 16 + swz / 64; C = (st & 1) * 32 + (swz % 64) / 2; }
__device__ __forceinline__ int perm32(int rho) { const int n = rho >> 4, i = rho & 15; return 8 * (i >> 2) + 4 * n + (i & 3); }

struct Unit { int pm, pn, e; };

template <class Epi, class Sched>
__device__ __forceinline__ void gemm_phase(LAS unsigned char* lds, const Sched& S, const Epi& E) {
    int tid_ = threadIdx.x; asm volatile("" : "+v"(tid_)); const int tid = tid_, wid = __builtin_amdgcn_readfirstlane(tid >> 6), lane = tid & 63, wr = wid >> 2, wc = wid & 3, fr = lane & 15, fq = lane >> 4;
    const int K = S.K, nt = K / BK;
    unsigned voffA[2], voffB[2];
#pragma unroll
    for (int i = 0; i < 2; ++i) { int R, C; stage_rc(tid * 16 + i * 8192, R, C); const int Rb = Epi::PERM ? ((R & ~31) + perm32(R & 31)) : R;
        voffA[i] = (unsigned)(R * S.lda + C) * 2u; voffB[i] = (unsigned)(Rb * S.ldb + C) * 2u; }
    const size_t kstep = (size_t)(BK * 2);
    const size_t hstepA = (size_t)HALF * S.lda * 2, hstepB = (size_t)HALF * S.ldb * 2;
    const unsigned ldsw = (unsigned)wid * 1024u;
    const int aoff = lds_byte(wr * 64 + fr, fq * 8), boff = lds_byte(wc * 32 + fr, fq * 8);
#define PG8_SA(b, h) (((b) * 2 + (h)) * HTB)
#define PG8_SB(b, h) ((4 + (b) * 2 + (h)) * HTB)
#define PG8_STAGE(bufoff, gbase, voff) do { _Pragma("unroll") for (int _i = 0; _i < 2; ++_i) \
        __builtin_amdgcn_global_load_lds((const unsigned*)((const char*)(gbase) + (voff)[_i]), (LAS unsigned*)(lds + (bufoff) + ldsw + _i * 8192), 16, 0, 0); } while (0)
#define PG8_LDA(dst, b, h) do { _Pragma("unroll") for (int m = 0; m < 4; ++m) _Pragma("unroll") for (int k = 0; k < 2; ++k) dst[m][k] = *(const LAS bf16x8*)(lds + PG8_SA(b, h) + aoff + m * 2048 + k * 1024); } while (0)
#define PG8_LDB(dst, b, h) do { _Pragma("unroll") for (int n = 0; n < 2; ++n) _Pragma("unroll") for (int k = 0; k < 2; ++k) dst[n][k] = *(const LAS bf16x8*)(lds + PG8_SB(b, h) + boff + n * 2048 + k * 1024); } while (0)
#define PG8_MMA(ai, bj, At, Bt) do { __builtin_amdgcn_s_setprio(1); _Pragma("unroll") for (int m = 0; m < 4; ++m) _Pragma("unroll") for (int n = 0; n < 2; ++n) _Pragma("unroll") for (int k = 0; k < 2; ++k) \
        acc[ai][bj][m][n] = __builtin_amdgcn_mfma_f32_16x16x32_bf16(Bt[n][k], At[m][k], acc[ai][bj][m][n], 0, 0, 0); __builtin_amdgcn_s_setprio(0); } while (0)
#define PG8_WAIT_V(n) asm volatile("s_waitcnt vmcnt(" #n ")" ::: "memory")
#define PG8_WAIT_L(n) asm volatile("s_waitcnt lgkmcnt(" #n ")" ::: "memory")
#define PG8_BAR __builtin_amdgcn_s_barrier()
#define PG8_SCHED __builtin_amdgcn_sched_barrier(0)
    Unit cur, nxt; int ui = 0;
    if (!S.next(0, cur)) return;
    f32x4 acc[2][2][4][2];
#pragma unroll
    for (int a = 0; a < 2; ++a)
#pragma unroll
        for (int b = 0; b < 2; ++b)
#pragma unroll
            for (int m = 0; m < 4; ++m)
#pragma unroll
                for (int n = 0; n < 2; ++n) acc[a][b][m][n] = (f32x4){0.f, 0.f, 0.f, 0.f};
    bf16x8 At[4][2], B0[2][2], B1[2][2];
    const char* cA = S.aptr(cur); const char* cB = S.bptr(cur);
    PG8_STAGE(PG8_SB(0, 0), cB, voffB); PG8_STAGE(PG8_SA(0, 0), cA, voffA); PG8_STAGE(PG8_SB(0, 1), cB + hstepB, voffB); PG8_STAGE(PG8_SA(0, 1), cA + hstepA, voffA);
    if (wr == 1) PG8_BAR;
    PG8_WAIT_V(4); PG8_BAR;
    PG8_STAGE(PG8_SB(1, 0), cB + kstep, voffB); PG8_STAGE(PG8_SA(1, 0), cA + kstep, voffA); PG8_STAGE(PG8_SB(1, 1), cB + hstepB + kstep, voffB);
    PG8_WAIT_V(6); PG8_BAR;
    for (;;) {
        const bool has_next = S.next(ui + 1, nxt);
        const char* nA = has_next ? S.aptr(nxt) : cA; const char* nB = has_next ? S.bptr(nxt) : cB;
        for (int t = 0; t < nt; t += 2) {
            const bool last = (t == nt - 2);
            const char* a1 = cA + (size_t)(t + 1) * kstep;
            const char* a2 = last ? nA : cA + (size_t)(t + 2) * kstep; const char* b2 = last ? nB : cB + (size_t)(t + 2) * kstep;
            const char* a3 = a2 + kstep; const char* b3 = b2 + kstep;
            PG8_LDB(B0, 0, 0); PG8_SCHED; PG8_LDA(At, 0, 0); PG8_STAGE(PG8_SA(1, 1), a1 + hstepA, voffA);
            PG8_WAIT_L(8); PG8_BAR; PG8_WAIT_L(0); PG8_MMA(0, 0, At, B0); PG8_BAR; PG8_SCHED;
            PG8_LDB(B1, 0, 1); PG8_STAGE(PG8_SB(0, 0), b2, voffB);
            PG8_BAR; PG8_WAIT_L(0); PG8_MMA(0, 1, At, B1); PG8_BAR;
            PG8_LDA(At, 0, 1); PG8_STAGE(PG8_SA(0, 0), a2, voffA);
            PG8_BAR; PG8_WAIT_L(0); PG8_MMA(1, 0, At, B0); PG8_BAR; PG8_SCHED;
            PG8_STAGE(PG8_SB(0, 1), b2 + hstepB, voffB);
            PG8_WAIT_V(6); PG8_BAR; PG8_MMA(1, 1, At, B1); PG8_BAR;
            PG8_LDB(B0, 1, 0); PG8_SCHED; PG8_LDA(At, 1, 0); PG8_STAGE(PG8_SA(0, 1), a2 + hstepA, voffA);
            PG8_WAIT_L(8); PG8_BAR; PG8_WAIT_L(0); PG8_MMA(0, 0, At, B0); PG8_BAR; PG8_SCHED;
            PG8_LDB(B1, 1, 1); PG8_STAGE(PG8_SB(1, 0), b3, voffB);
            PG8_BAR; PG8_WAIT_L(0); PG8_MMA(0, 1, At, B1); PG8_BAR;
            PG8_LDA(At, 1, 1); PG8_STAGE(PG8_SA(1, 0), a3, voffA);
            PG8_BAR; PG8_WAIT_L(0); PG8_MMA(1, 0, At, B0); PG8_BAR; PG8_SCHED;
            PG8_STAGE(PG8_SB(1, 1), b3 + hstepB, voffB);
            PG8_WAIT_V(6); PG8_BAR; PG8_MMA(1, 1, At, B1); PG8_BAR;
        }
        if constexpr (!Epi::AFTER_DRAIN) { int fr_ = fr, fq_ = fq; asm volatile("" : "+v"(fr_), "+v"(fq_)); E(acc, cur, wr, wc, fr_, fq_); }
        if (!has_next) break;
#pragma unroll
        for (int a = 0; a < 2; ++a)
#pragma unroll
            for (int b = 0; b < 2; ++b)
#pragma unroll
                for (int m = 0; m < 4; ++m)
#pragma unroll
                    for (int n = 0; n < 2; ++n) acc[a][b][m][n] = (f32x4){0.f, 0.f, 0.f, 0.f};
        cur = nxt; cA = nA; cB = nB; ++ui;
    }
    PG8_WAIT_V(0);
    if (wr == 0) PG8_BAR;
    PG8_BAR;
    if constexpr (Epi::AFTER_DRAIN) { int fr_ = fr, fq_ = fq; asm volatile("" : "+v"(fr_), "+v"(fq_)); E.fused(acc, cur, wr, wc, fr_, fq_, lds, wid, lane); }
#undef PG8_SA
#undef PG8_SB
#undef PG8_STAGE
#undef PG8_LDA
#undef PG8_LDB
#undef PG8_MMA
#undef PG8_WAIT_V
#undef PG8_WAIT_L
#undef PG8_BAR
#undef PG8_SCHED
}

struct DenseOrder {
    const char* A; const char* Bt; int lda, ldb, K; int nM, nN, nwg, G, c;
    __device__ void init(const void* A_, const void* Bt_, int M, int N, int K_, int lda_, int ldb_, int G_, int c_) { A = (const char*)A_; Bt = (const char*)Bt_; K = K_; lda = lda_; ldb = ldb_; nM = M / BM; nN = N / BM; nwg = nM * nN; G = G_; c = c_; }
    __device__ bool next(int i, Unit& u) const {
        const long L = (long)i * G + c; if (L >= nwg) return false;
        int wgid = (int)L; { const int q = nwg / NXCD, r = nwg % NXCD, xcd = wgid % NXCD, off = wgid / NXCD; wgid = (xcd < r ? xcd * (q + 1) : r * (q + 1) + (xcd - r) * q) + off; }
        const int nig = WGM * nN, gid = wgid / nig, fm = gid * WGM, gsz = (nM - fm) < WGM ? (nM - fm) : WGM;
        u.pm = fm + ((wgid % nig) % gsz); u.pn = (wgid % nig) / gsz; u.e = 0; return true;
    }
    __device__ __forceinline__ const char* aptr(const Unit& u) const { return A + (size_t)u.pm * BM * lda * 2; }
    __device__ __forceinline__ const char* bptr(const Unit& u) const { return Bt + (size_t)u.pn * BM * ldb * 2; }
};
struct KvOrder {
    const char* memb; const char* wkv; int lda, ldb, K, G, c;
    __device__ bool next(int i, Unit& u) const {
        const int L = i * G + c; if (L >= 128) return false;
        const int layer = L >> 6, rem = L & 63;
        if (rem < 32) { u.pm = rem >> 2; u.pn = rem & 3; u.e = layer * 2; }
        else { u.pm = (rem - 32) >> 3; u.pn = (rem - 32) & 7; u.e = layer * 2 + 1; }
        return true;
    }
    __device__ __forceinline__ const char* aptr(const Unit& u) const {
        const int layer = u.e >> 1;
        return (u.e & 1) ? wkv + ((size_t)layer * 2048 + 1024 + (size_t)u.pm * 256) * 2048 : memb + (size_t)u.pm * 256 * 2048;
    }
    __device__ __forceinline__ const char* bptr(const Unit& u) const {
        const int layer = u.e >> 1;
        return (u.e & 1) ? memb + (size_t)u.pn * 256 * 2048 : wkv + ((size_t)layer * 2048 + (size_t)u.pn * 256) * 2048;
    }
};
struct SOrder {
    const char* Q; const char* Kb; int lda, ldb, K, G, c;
    __device__ bool next(int i, Unit& u) const { const int L = i * G + c; if (L >= 256) return false; u.pm = L & 7; u.pn = 0; u.e = L >> 3; return true; }
    __device__ __forceinline__ const char* aptr(const Unit& u) const { const int b = u.e >> 2, hd = u.e & 3; return Q + (((size_t)b * 2048 + (size_t)u.pm * 256) * 1024 + hd * 256) * 2; }
    __device__ __forceinline__ const char* bptr(const Unit& u) const { const int b = u.e >> 2, hd = u.e & 3; return Kb + (((size_t)b * 256) * 1024 + hd * 256) * 2; }
};
struct PvOrder {
    const char* P; const char* Vt; int lda, ldb, K, G, c;
    __device__ bool next(int i, Unit& u) const { const int L = i * G + c; if (L >= 256) return false; u.pm = L & 7; u.pn = 0; u.e = L >> 3; return true; }
    __device__ __forceinline__ const char* aptr(const Unit& u) const { return P + (((size_t)u.e * 2048 + (size_t)u.pm * 256) * 256) * 2; }
    __device__ __forceinline__ const char* bptr(const Unit& u) const { const int b = u.e >> 2, hd = u.e & 3; return Vt + (((size_t)hd * 256) * 2048 + (size_t)b * 256) * 2; }
};
struct MoeOrder {
    const char* A; const char* W; LAS const int* ul; size_t wstride; int lda, ldb, K;
    __device__ bool next(int i, Unit& u) const {
        if (i >= 16) return false;
        const int pm = __builtin_amdgcn_readfirstlane(ul[3 * i]); if (pm < 0) return false;
        u.pm = pm; u.pn = __builtin_amdgcn_readfirstlane(ul[3 * i + 1]); u.e = __builtin_amdgcn_readfirstlane(ul[3 * i + 2]); return true;
    }
    __device__ __forceinline__ const char* aptr(const Unit& u) const { return A + (size_t)u.pm * 256 * lda * 2; }
    __device__ __forceinline__ const char* bptr(const Unit& u) const { return W + (size_t)u.e * wstride + (size_t)u.pn * 256 * ldb * 2; }
};

struct EpiF32 {
    static constexpr bool PERM = false, AFTER_DRAIN = false;
    float* C; int ldc;
    __device__ __forceinline__ void operator()(const f32x4 (&acc)[2][2][4][2], const Unit& u, int wr, int wc, int fr, int fq) const {
        const int row0 = u.pm * BM + wr * 64 + fr, col0 = u.pn * BM + wc * 32 + 4 * fq;
#pragma unroll
        for (int ai = 0; ai < 2; ++ai)
#pragma unroll
            for (int m = 0; m < 4; ++m) { float* rowp = C + (size_t)(row0 + ai * HALF + m * 16) * ldc + col0;
#pragma unroll
                for (int bj = 0; bj < 2; ++bj)
#pragma unroll
                    for (int n = 0; n < 2; ++n) *(f32x4*)(rowp + bj * HALF + n * 16) = acc[ai][bj][m][n]; }
    }
};
__device__ __forceinline__ void store_bf16_tile(const f32x4 (&acc)[2][2][4][2], bf16_t* base, int ldc, float sc, int wr, int wc, int fr, int fq) {
    const int row0 = wr * 64 + fr, col0 = wc * 32 + 8 * fq;
#pragma unroll
    for (int ai = 0; ai < 2; ++ai)
#pragma unroll
        for (int m = 0; m < 4; ++m) { bf16_t* rowp = base + (size_t)(row0 + ai * HALF + m * 16) * ldc + col0;
#pragma unroll
            for (int bj = 0; bj < 2; ++bj) { const f32x4 v0 = acc[ai][bj][m][0] * sc, v1 = acc[ai][bj][m][1] * sc;
                u32x4 w; w.x = cvt_pk_bf16(v0[0], v0[1]); w.y = cvt_pk_bf16(v0[2], v0[3]); w.z = cvt_pk_bf16(v1[0], v1[1]); w.w = cvt_pk_bf16(v1[2], v1[3]);
                *(u32x4*)(rowp + bj * HALF) = w; } }
}
struct EpiBf16 {
    static constexpr bool PERM = true, AFTER_DRAIN = false;
    bf16_t* O; int ldc; float scale;
    __device__ __forceinline__ void operator()(const f32x4 (&acc)[2][2][4][2], const Unit& u, int wr, int wc, int fr, int fq) const {
        store_bf16_tile(acc, O + (size_t)u.pm * BM * ldc + u.pn * BM, ldc, scale, wr, wc, fr, fq);
    }
};
struct EpiProj {
    static constexpr bool PERM = true, AFTER_DRAIN = false;
    bf16_t* O; float* gates;
    __device__ __forceinline__ void operator()(const f32x4 (&acc)[2][2][4][2], const Unit& u, int wr, int wc, int fr, int fq) const {
        store_bf16_tile(acc, O + (size_t)u.pm * BM * NPROJ + u.pn * BM, NPROJ, 1.0f, wr, wc, fr, fq);
        if (u.pn == 15 && wc == 0 && fq == 0) {
#pragma unroll
            for (int ai = 0; ai < 2; ++ai)
#pragma unroll
                for (int m = 0; m < 4; ++m) { float* g = gates + (size_t)(u.pm * BM + ai * HALF + wr * 64 + m * 16 + fr) * 8;
                    *(f32x4*)g = acc[ai][0][m][0]; *(f32x4*)(g + 4) = acc[ai][0][m][1]; }
        }
    }
};
struct EpiKv {
    static constexpr bool PERM = true, AFTER_DRAIN = false;
    bf16_t* Kb; bf16_t* Vt;
    __device__ __forceinline__ void operator()(const f32x4 (&acc)[2][2][4][2], const Unit& u, int wr, int wc, int fr, int fq) const {
        const int layer = u.e >> 1;
        if (u.e & 1) store_bf16_tile(acc, Vt + (size_t)layer * 1024 * 2048 + (size_t)u.pm * BM * 2048 + u.pn * BM, 2048, 1.0f, wr, wc, fr, fq);
        else store_bf16_tile(acc, Kb + (size_t)layer * 2048 * 1024 + (size_t)u.pm * BM * 1024 + u.pn * BM, 1024, 1.0f, wr, wc, fr, fq);
    }
};
struct EpiPv {
    static constexpr bool PERM = true, AFTER_DRAIN = false;
    bf16_t* O;
    __device__ __forceinline__ void operator()(const f32x4 (&acc)[2][2][4][2], const Unit& u, int wr, int wc, int fr, int fq) const {
        const int b = u.e >> 2, hd = u.e & 3;
        store_bf16_tile(acc, O + ((size_t)b * 2048 + (size_t)u.pm * 256) * 1024 + hd * 256, 1024, 1.0f, wr, wc, fr, fq);
    }
};
struct EpiSoftmax {
    static constexpr bool PERM = true, AFTER_DRAIN = true;
    bf16_t* P;
    __device__ __forceinline__ void fused(f32x4 (&acc)[2][2][4][2], const Unit& u, int wr, int wc, int fr, int fq, LAS unsigned char* lds, int wid, int lane) const {
        LAS f32x2* tab = (LAS f32x2*)lds;
#pragma unroll
        for (int ai = 0; ai < 2; ++ai)
#pragma unroll
            for (int m = 0; m < 4; ++m) {
                float mx = -3.0e38f;
#pragma unroll
                for (int bj = 0; bj < 2; ++bj)
#pragma unroll
                    for (int n = 0; n < 2; ++n) { const f32x4 x = acc[ai][bj][m][n]; mx = fmaxf(mx, fmaxf(fmaxf(x[0], x[1]), fmaxf(x[2], x[3]))); }
                mx = fmaxf(mx, __shfl_xor(mx, 16)); mx = fmaxf(mx, __shfl_xor(mx, 32));
                float s = 0.f;
#pragma unroll
                for (int bj = 0; bj < 2; ++bj)
#pragma unroll
                    for (int n = 0; n < 2; ++n) { const f32x4 x = acc[ai][bj][m][n]; s += (__expf(x[0] - mx) + __expf(x[1] - mx)) + (__expf(x[2] - mx) + __expf(x[3] - mx)); }
                s += __shfl_xor(s, 16); s += __shfl_xor(s, 32);
                if (fq == 0) tab[(ai * HALF + wr * 64 + m * 16 + fr) * 4 + wc] = (f32x2){mx, s};
            }
        LDS_WAIT(); __builtin_amdgcn_s_barrier(); asm volatile("" ::: "memory");
        bf16_t* base = P + ((size_t)u.e * 2048 + (size_t)u.pm * 256) * 256;
#pragma unroll
        for (int ai = 0; ai < 2; ++ai)
#pragma unroll
            for (int m = 0; m < 4; ++m) { const int r = ai * HALF + wr * 64 + m * 16 + fr;
                const f32x2 p0 = tab[r * 4 + 0], p1 = tab[r * 4 + 1], p2 = tab[r * 4 + 2], p3 = tab[r * 4 + 3];
                const float M = fmaxf(fmaxf(p0.x, p1.x), fmaxf(p2.x, p3.x));
                const float ssum = p0.y * __expf(p0.x - M) + p1.y * __expf(p1.x - M) + p2.y * __expf(p2.x - M) + p3.y * __expf(p3.x - M);
                const float inv = 1.0f / ssum;
                bf16_t* rowp = base + (size_t)r * 256 + wc * 32 + 8 * fq;
#pragma unroll
                for (int bj = 0; bj < 2; ++bj) { const f32x4 x0 = acc[ai][bj][m][0], x1 = acc[ai][bj][m][1];
                    u32x4 w; w.x = cvt_pk_bf16(__expf(x0[0] - M) * inv, __expf(x0[1] - M) * inv); w.y = cvt_pk_bf16(__expf(x0[2] - M) * inv, __expf(x0[3] - M) * inv);
                    w.z = cvt_pk_bf16(__expf(x1[0] - M) * inv, __expf(x1[1] - M) * inv); w.w = cvt_pk_bf16(__expf(x1[2] - M) * inv, __expf(x1[3] - M) * inv);
                    *(u32x4*)(rowp + bj * HALF) = w; } }
        LDS_WAIT(); __builtin_amdgcn_s_barrier(); asm volatile("" ::: "memory");
    }
};
struct EpiSwiglu {
    static constexpr bool PERM = true, AFTER_DRAIN = false;
    bf16_t* G; const float* b1;
    __device__ __forceinline__ void operator()(const f32x4 (&acc)[2][2][4][2], const Unit& u, int wr, int wc, int fr, int fq) const {
        const int cin = wc * 32 + 8 * fq;
        const float* bg = b1 + (size_t)u.e * 2048 + u.pn * 128 + cin; const float* bu = bg + 1024;
        const f32x4 g0 = *(const f32x4*)bg, g1 = *(const f32x4*)(bg + 4), u0 = *(const f32x4*)bu, u1 = *(const f32x4*)(bu + 4);
#pragma unroll
        for (int ai = 0; ai < 2; ++ai)
#pragma unroll
            for (int m = 0; m < 4; ++m) {
                bf16_t* rowp = G + (size_t)(u.pm * BM + ai * HALF + wr * 64 + m * 16 + fr) * 1024 + u.pn * 128 + cin;
                float o[8];
#pragma unroll
                for (int n = 0; n < 2; ++n) { const f32x4 ga = acc[ai][0][m][n] + (n ? g1 : g0), up = acc[ai][1][m][n] + (n ? u1 : u0);
#pragma unroll
                    for (int j = 0; j < 4; ++j) { const float gt = fminf(ga[j], 7.0f), uu = fminf(fmaxf(up[j], -7.0f), 7.0f);
                        const float glu = gt / (1.0f + __expf(-1.702f * gt)); o[n * 4 + j] = (uu + 1.0f) * glu; } }
                u32x4 w; w.x = cvt_pk_bf16(o[0], o[1]); w.y = cvt_pk_bf16(o[2], o[3]); w.z = cvt_pk_bf16(o[4], o[5]); w.w = cvt_pk_bf16(o[6], o[7]);
                *(u32x4*)rowp = w; }
    }
};
struct EpiMoeY {
    static constexpr bool PERM = true, AFTER_DRAIN = false;
    bf16_t* Y; const float* b2;
    __device__ __forceinline__ void operator()(const f32x4 (&acc)[2][2][4][2], const Unit& u, int wr, int wc, int fr, int fq) const {
        const int col0 = u.pn * BM + wc * 32 + 8 * fq;
        f32x4 bv[2][2];
#pragma unroll
        for (int bj = 0; bj < 2; ++bj)
#pragma unroll
            for (int n = 0; n < 2; ++n) bv[bj][n] = *(const f32x4*)(b2 + (size_t)u.e * 1024 + col0 + bj * HALF + 4 * n);
#pragma unroll
        for (int ai = 0; ai < 2; ++ai)
#pragma unroll
            for (int m = 0; m < 4; ++m) { bf16_t* rowp = Y + (size_t)(u.pm * BM + ai * HALF + wr * 64 + m * 16 + fr) * 1024 + col0;
#pragma unroll
                for (int bj = 0; bj < 2; ++bj) { const f32x4 v0 = acc[ai][bj][m][0] + bv[bj][0], v1 = acc[ai][bj][m][1] + bv[bj][1];
                    u32x4 w; w.x = cvt_pk_bf16(v0[0], v0[1]); w.y = cvt_pk_bf16(v0[2], v0[3]); w.z = cvt_pk_bf16(v1[0], v1[1]); w.w = cvt_pk_bf16(v1[2], v1[3]);
                    *(u32x4*)(rowp + bj * HALF) = w; } }
    }
};
}

struct Args { const float* in[37]; float* out; unsigned char* ws; int ph_lo, ph_hi; };
constexpr int TAB_OFF = MISC_OFF + 8192;
struct InTab {
    LAS const volatile unsigned* t;
    __device__ __forceinline__ unsigned long long geti(int k) const { unsigned lo = t[2 * k], hi = t[2 * k + 1]; lo = __builtin_amdgcn_readfirstlane(lo); hi = __builtin_amdgcn_readfirstlane(hi); return ((unsigned long long)hi << 32) | lo; }
    __device__ __forceinline__ const float* operator[](int k) const { return (const float*)(const __attribute__((address_space(1))) float*)geti(k); }
};
struct Ctx {
    LAS unsigned char* lds; int tid, lane, wave, blk, G, gw, ngw;
    InTab in; float* out; unsigned long long wsi;
};
#define GAS __attribute__((address_space(1)))
template <class Tp> __device__ __forceinline__ Tp* wsp(const Ctx& F, size_t off) { return (Tp*)(GAS Tp*)(F.wsi + off); }

__device__ __forceinline__ void ln_row_store(f32x4 (&v)[4], const float* g, const float* b, float* hrow, bf16_t* hbrow, int lane) {
    float s = 0.f;
#pragma unroll
    for (int j = 0; j < 4; ++j) s += (v[j][0] + v[j][1]) + (v[j][2] + v[j][3]);
    const float mean = wave_sum(s) * (1.0f / 1024.0f); float s2 = 0.f;
#pragma unroll
    for (int j = 0; j < 4; ++j) { v[j] = v[j] - mean; s2 += (v[j][0] * v[j][0] + v[j][1] * v[j][1]) + (v[j][2] * v[j][2] + v[j][3] * v[j][3]); }
    const float rstd = 1.0f / sqrtf(wave_sum(s2) * (1.0f / 1024.0f) + 1e-5f);
#pragma unroll
    for (int j = 0; j < 4; ++j) {
        const f32x4 gg = *(const f32x4*)(g + 256 * j + 4 * lane), bb = *(const f32x4*)(b + 256 * j + 4 * lane);
        const f32x4 o = v[j] * rstd * gg + bb;
        *(f32x4*)(hrow + 256 * j + 4 * lane) = o;
        if (hbrow) { u32x2 w; w.x = pk2(o[0], o[1]); w.y = pk2(o[2], o[3]); *(u32x2*)(hbrow + 256 * j + 4 * lane) = w; }
    }
}

__device__ __forceinline__ int map_row(int kind, int n) {
    if (kind == 1) return n < 2048 ? n : (n < 2056 ? 3840 + (n - 2048) : n - 8);
    if (kind == 2) { const int j = n & 1023; return (j >> 7) * 256 + ((n >> 10) << 7) + (j & 127); }
    return n;
}
__device__ __forceinline__ void transpose_item(const float* W, int N, bf16_t* WT, int kind, LAS float* scr, int item, int lane) {
    const int nblk = (N + 63) >> 6, kb = item / nblk, nb = item % nblk, k0 = 64 * kb, n0 = 64 * nb;
    const int kl = lane >> 4, n4 = (lane & 15) * 4; const bool ok = (n0 + n4) < N;
    f32x4 v[16];
#pragma unroll
    for (int i = 0; i < 16; ++i) v[i] = ok ? *(const f32x4*)(W + (size_t)(k0 + 4 * i + kl) * N + n0 + n4) : (f32x4){0.f, 0.f, 0.f, 0.f};
#pragma unroll
    for (int i = 0; i < 16; ++i) { LAS float* d = scr + (4 * i + kl) * 65 + n4; d[0] = v[i][0]; d[1] = v[i][1]; d[2] = v[i][2]; d[3] = v[i][3]; }
    LDS_WAIT(); asm volatile("" ::: "memory");
    const int c = lane & 7;
#pragma unroll
    for (int j = 0; j < 8; ++j) { const int n = (lane >> 3) + 8 * j; const LAS float* sp = scr + (8 * c) * 65 + n;
        if (n0 + n < N) { u32x4 o; o.x = cvt_pk_bf16(sp[0 * 65], sp[1 * 65]); o.y = cvt_pk_bf16(sp[2 * 65], sp[3 * 65]); o.z = cvt_pk_bf16(sp[4 * 65], sp[5 * 65]); o.w = cvt_pk_bf16(sp[6 * 65], sp[7 * 65]);
            *(u32x4*)(WT + (size_t)map_row(kind, n0 + n) * 1024 + k0 + 8 * c) = o; } }
    LDS_WAIT(); asm volatile("" ::: "memory");
}
__device__ __forceinline__ void phase_prologue(const Ctx& F) {
    LAS float* scr = (LAS float*)(F.lds + F.wave * 16640);
    constexpr int I_IN = 16 * 61, I_SQ = 16 * 16, I_KV = 16 * 32, I_W1 = 16 * 32, I_W2 = 16 * 16;
    constexpr int PER_LAYER = I_IN + 3 * I_SQ + I_KV + 32 * I_W1 + 32 * I_W2;
    const float* p_win = F.in[4]; const float* p_wout = F.in[21]; const float* p_wq = F.in[24]; const float* p_wkv = F.in[25]; const float* p_wo = F.in[26]; const float* p_w1 = F.in[31]; const float* p_w2 = F.in[33];
    for (int it = F.gw; it < 2 * PER_LAYER; it += F.ngw) {
        const int l = it / PER_LAYER; int r = it % PER_LAYER;
        if (r < I_IN) { transpose_item(p_win + (size_t)l * 1024 * IN_COLS, IN_COLS, wsp<bf16_t>(F, WS_WIN) + (size_t)l * 4096 * 1024, 1, scr, r, F.lane); continue; } r -= I_IN;
        if (r < I_SQ) { transpose_item(p_wout + (size_t)l * 1024 * 1024, 1024, wsp<bf16_t>(F, WS_WOUT) + (size_t)l * 1024 * 1024, 0, scr, r, F.lane); continue; } r -= I_SQ;
        if (r < I_SQ) { transpose_item(p_wq + (size_t)l * 1024 * 1024, 1024, wsp<bf16_t>(F, WS_WQ) + (size_t)l * 1024 * 1024, 0, scr, r, F.lane); continue; } r -= I_SQ;
        if (r < I_KV) { transpose_item(p_wkv + (size_t)l * 1024 * 2048, 2048, wsp<bf16_t>(F, WS_WKV) + (size_t)l * 2048 * 1024, 0, scr, r, F.lane); continue; } r -= I_KV;
        if (r < I_SQ) { transpose_item(p_wo + (size_t)l * 1024 * 1024, 1024, wsp<bf16_t>(F, WS_WO) + (size_t)l * 1024 * 1024, 0, scr, r, F.lane); continue; } r -= I_SQ;
        if (r < 32 * I_W1) { const int e = r / I_W1; transpose_item(p_w1 + ((size_t)l * 32 + e) * 1024 * 2048, 2048, wsp<bf16_t>(F, WS_W1) + ((size_t)l * 32 + e) * 2048 * 1024, 2, scr, r % I_W1, F.lane); continue; } r -= 32 * I_W1;
        { const int e = r / I_W2; transpose_item(p_w2 + ((size_t)l * 32 + e) * 1024 * 1024, 1024, wsp<bf16_t>(F, WS_W2) + ((size_t)l * 32 + e) * 1024 * 1024, 0, scr, r % I_W2, F.lane); }
    }
    const int gt = F.blk * NTHREADS + F.tid, ngt = F.G * NTHREADS;
    for (int i = gt; i < 2 * 248 * 128; i += ngt) { const int l = i / (248 * 128), r = i % (248 * 128); *(u32x4*)(wsp<bf16_t>(F, WS_WIN) + ((size_t)l * 4096 + 3848) * 1024 + (size_t)r * 8) = (u32x4){0u, 0u, 0u, 0u}; }
    const float* pw2 = F.in[12]; const float* pa2 = F.in[14]; const float* pg2 = F.in[15];
    for (int i = gt; i < 2 * 1536 * 256; i += ngt) {
        const int l = i / (1536 * 256), r = i % (1536 * 256), n = r >> 8, k = r & 255; float v = 0.f;
        if (n < 512) { if (k < 64) v = pw2[((size_t)l * 64 + k) * 512 + n]; }
        else if (n < 1024) { if (k >= 64 && k < 128) v = pa2[((size_t)l * 64 + (k - 64)) * 512 + (n - 512)]; }
        else { if (k >= 128) v = pg2[((size_t)l * 128 + (k - 128)) * 512 + (n - 1024)]; }
        wsp<bf16_t>(F, WS_WLR)[i] = (bf16_t)f2bf(v);
    }
    const f32x4* pmem = (const f32x4*)F.in[1];
    for (int i = gt; i < 2048 * 1024 / 4; i += ngt) { const f32x4 v = pmem[i]; u32x2 w; w.x = pk2(v[0], v[1]); w.y = pk2(v[2], v[3]); ((u32x2*)wsp<bf16_t>(F, WS_MEMB))[i] = w; }
    const float* px = F.in[0]; const float* pg0 = F.in[2]; const float* pb0 = F.in[3];
    for (int m = F.gw; m < T_TOK; m += F.ngw) {
        f32x4 v[4]; const float* xr = px + (size_t)m * DM;
#pragma unroll
        for (int j = 0; j < 4; ++j) v[j] = *(const f32x4*)(xr + 256 * j + 4 * F.lane);
        ln_row_store(v, pg0, pb0, wsp<float>(F, WS_H) + (size_t)m * DM, wsp<bf16_t>(F, WS_HB) + (size_t)m * DM, F.lane);
    }
}

__device__ __forceinline__ void phase_ln_add(const Ctx& F, const float* g, const float* b) {
    for (int m = F.gw; m < T_TOK; m += F.ngw) {
        f32x4 v[4]; const float* hr = wsp<float>(F, WS_H) + (size_t)m * DM; const float* cr = wsp<float>(F, WS_CF) + (size_t)m * DM;
#pragma unroll
        for (int j = 0; j < 4; ++j) v[j] = *(const f32x4*)(hr + 256 * j + 4 * F.lane) * DN_ALPHA + *(const f32x4*)(cr + 256 * j + 4 * F.lane);
        ln_row_store(v, g, b, wsp<float>(F, WS_H) + (size_t)m * DM, wsp<bf16_t>(F, WS_HB) + (size_t)m * DM, F.lane);
    }
}
__device__ __forceinline__ void phase_ln_moe(const Ctx& F, const float* g, const float* b, bool last) {
    const int* slot = wsp<int>(F, SM_SLOT); const float* tg = wsp<float>(F, SM_TOPG); const bf16_t* Y = wsp<bf16_t>(F, WS_YB);
    for (int m = F.gw; m < T_TOK; m += F.ngw) {
        f32x4 v[4]; const float* hr = wsp<float>(F, WS_H) + (size_t)m * DM;
#pragma unroll
        for (int j = 0; j < 4; ++j) v[j] = *(const f32x4*)(hr + 256 * j + 4 * F.lane) * DN_ALPHA;
#pragma unroll
        for (int k = 0; k < 4; ++k) { const int sl = slot[m * 4 + k]; const float gk = tg[m * 4 + k]; const bf16_t* yr = Y + (size_t)sl * DM;
#pragma unroll
            for (int j = 0; j < 4; ++j) { const u32x2 w = *(const u32x2*)(yr + 256 * j + 4 * F.lane);
                v[j][0] += gk * bflo(w.x); v[j][1] += gk * bfhi(w.x); v[j][2] += gk * bflo(w.y); v[j][3] += gk * bfhi(w.y); } }
        float* dst = last ? F.out + (size_t)m * DM : wsp<float>(F, WS_H) + (size_t)m * DM;
        ln_row_store(v, g, b, dst, last ? (bf16_t*)nullptr : wsp<bf16_t>(F, WS_HB) + (size_t)m * DM, F.lane);
    }
}

__device__ __forceinline__ void phase_xlr(const Ctx& F, int l) {
    const bf16_t* proj = wsp<bf16_t>(F, WS_PROJ); bf16_t* xlr = wsp<bf16_t>(F, WS_XLR); const float* mu = F.in[10] + (size_t)l * 1792 + 1536;
    const int gt = F.blk * NTHREADS + F.tid, ngt = F.G * NTHREADS;
    for (int i = gt; i < T_TOK * 32; i += ngt) {
        const int t = i >> 5, c8 = (i & 31) * 8;
        const u32x4 p = *(const u32x4*)(proj + (size_t)t * NPROJ + RC0 + 1536 + c8);
        u32x4 q = (u32x4){0u, 0u, 0u, 0u}; if ((t & (SEQ - 1)) != 0) q = *(const u32x4*)(proj + (size_t)(t - 1) * NPROJ + RC0 + 1536 + c8);
        float o[8];
#pragma unroll
        for (int j = 0; j < 4; ++j) { const float a0 = bflo(p[j]), a1 = bfhi(p[j]), b0 = bflo(q[j]), b1 = bfhi(q[j]);
            o[2 * j] = a0 + (b0 - a0) * mu[c8 + 2 * j]; o[2 * j + 1] = a1 + (b1 - a1) * mu[c8 + 2 * j + 1]; }
#pragma unroll
        for (int j = 0; j < 8; ++j) { if (c8 < 64) o[j] = tanhf(o[j]); else if (c8 >= 128) o[j] = sigmoidf_(o[j]); }
        u32x4 w; w.x = pk2(o[0], o[1]); w.y = pk2(o[2], o[3]); w.z = pk2(o[4], o[5]); w.w = pk2(o[6], o[7]);
        *(u32x4*)(xlr + (size_t)t * 256 + c8) = w;
    }
}

template <int CTRL> __device__ __forceinline__ float dpp_f(float x) { return __builtin_bit_cast(float, __builtin_amdgcn_update_dpp(0, __builtin_bit_cast(int, x), CTRL, 0xF, 0xF, true)); }
__device__ __forceinline__ float allreduce16(float x) { x += dpp_f<0x128>(x); x += dpp_f<0x124>(x); x += dpp_f<0x122>(x); x += dpp_f<0x121>(x); return x; }
__device__ __forceinline__ f32x4 bf4(u32x2 w) { return (f32x4){bflo(w.x), bfhi(w.x), bflo(w.y), bfhi(w.y)}; }
__device__ __forceinline__ float hsum4(f32x4 v) { return (v[0] + v[1]) + (v[2] + v[3]); }
__device__ __forceinline__ void phase_rwkv_prep(const Ctx& F, int l) {
    const bf16_t* proj = wsp<bf16_t>(F, WS_PROJ); const float* lr = wsp<float>(F, WS_LR); float* rec = wsp<float>(F, WS_REC); float* gv = wsp<float>(F, WS_GV); float* bon = wsp<float>(F, SM_BON);
    const float* mu = F.in[10] + (size_t)l * 1792; const float* w0 = F.in[11] + l * 512; const float* a0 = F.in[13] + l * 512;
    const float* pkk = F.in[16] + l * 512; const float* pka = F.in[17] + l * 512; const float* prk = F.in[18] + l * 512;
    const int r = F.lane >> 4, g = F.lane & 15;
    for (int item = F.gw; item < T_TOK * 2; item += F.ngw) {
        const int t = item >> 1, h = (item & 1) * 4 + r, c = h * 64 + 4 * g, s = t & (SEQ - 1), bh = (t >> 11) * 8 + h;
        const bf16_t* pr = proj + (size_t)t * NPROJ + RC0 + c; const bool hasp = s != 0;
        f32x4 xr = bf4(*(const u32x2*)pr), xk = bf4(*(const u32x2*)(pr + 512)), xv = bf4(*(const u32x2*)(pr + 1024));
        f32x4 yr = (f32x4){0.f, 0.f, 0.f, 0.f}, yk = yr, yv = yr;
        if (hasp) { yr = bf4(*(const u32x2*)(pr - NPROJ)); yk = bf4(*(const u32x2*)(pr + 512 - NPROJ)); yv = bf4(*(const u32x2*)(pr + 1024 - NPROJ)); }
        xr = xr + (yr - xr) * *(const f32x4*)(mu + c); xk = xk + (yk - xk) * *(const f32x4*)(mu + 512 + c); xv = xv + (yv - xv) * *(const f32x4*)(mu + 1024 + c);
        const float* lrow = lr + (size_t)t * 1536 + c;
        const f32x4 wpre = *(const f32x4*)(w0 + c) + *(const f32x4*)lrow, apre = *(const f32x4*)(a0 + c) + *(const f32x4*)(lrow + 512), gg = *(const f32x4*)(lrow + 1024);
        const f32x4 vkk = *(const f32x4*)(pkk + c), vka = *(const f32x4*)(pka + c), vrk = *(const f32x4*)(prk + c);
        f32x4 d, a, kk, kp, beta;
#pragma unroll
        for (int j = 0; j < 4; ++j) { const float wl = -softplusf_(-wpre[j]) - 0.5f; d[j] = __expf(-__expf(wl)); a[j] = sigmoidf_(apre[j]); kk[j] = xk[j] * vkk[j]; kp[j] = xk[j] * (1.0f + (a[j] - 1.0f) * vka[j]); }
        const float nrm = sqrtf(allreduce16(hsum4(kk * kk))); const float inv = 1.0f / fmaxf(nrm, 1e-12f);
        kk = kk * inv; beta = kk * a;
        const float c1 = allreduce16(hsum4(beta * xr)), c2 = allreduce16(hsum4(kp * xr)), bs = allreduce16(hsum4(xr * kp * vrk));
        float* rp = rec + ((size_t)bh * SEQ + s) * RECF + 4 * g;
        *(f32x4*)rp = -kk; *(f32x4*)(rp + 64) = beta; *(f32x4*)(rp + 128) = d; *(f32x4*)(rp + 192) = kp; *(f32x4*)(rp + 256) = d * xr; *(f32x4*)(rp + 320) = xv;
        if (g == 0) { *(f32x4*)(rp + 384) = (f32x4){c1, c2, 0.f, 0.f}; bon[t * 8 + h] = bs; }
        *(f32x4*)(gv + (size_t)t * 512 + c) = gg;
    }
}

__device__ __forceinline__ void phase_rwkv_scan(const Ctx& F) {
    constexpr int TB = 16, CHF = TB * RECF, NCH = SEQ / TB;
    constexpr int BUFF = 7 * 256 * 4;
    LAS float* buf = (LAS float*)F.lds;
    LAS float* ybuf = (LAS float*)(F.lds + 2 * BUFF * 4);
    const int xcd = F.blk & 7, bi = F.blk >> 3, hd = (bi >> 2) * 8 + xcd, q = bi & 3, b = hd >> 3, h = hd & 7;
    const float* recbase = wsp<float>(F, WS_REC) + (size_t)hd * SEQ * RECF;
    float* yout = wsp<float>(F, WS_YR) + (size_t)b * SEQ * 512 + h * 64 + q * 16;
    if (F.wave >= 4) {
        const int j = F.tid - 256;
        f32x4 pre[7];
#pragma unroll
        for (int k = 0; k < 7; ++k) pre[k] = ((const f32x4*)recbase)[j + k * 256];
#pragma unroll
        for (int k = 0; k < 7; ++k) ((LAS f32x4*)buf)[j + k * 256] = pre[k];
#pragma unroll
        for (int k = 0; k < 7; ++k) pre[k] = ((const f32x4*)(recbase + CHF))[j + k * 256];
        LDS_WAIT(); __builtin_amdgcn_s_barrier(); asm volatile("" ::: "memory");
        for (int ci = 0; ci < NCH; ++ci) {
            if (ci + 1 < NCH) {
#pragma unroll
                for (int k = 0; k < 7; ++k) ((LAS f32x4*)(buf + ((ci + 1) & 1) * BUFF))[j + k * 256] = pre[k];
            }
            {   const int cn = ci + 2 < NCH ? ci + 2 : NCH - 1;
#pragma unroll
                for (int k = 0; k < 7; ++k) pre[k] = ((const f32x4*)(recbase + (size_t)cn * CHF))[j + k * 256];
            }
            if (ci > 0) { const LAS f32x4* yp = (const LAS f32x4*)(ybuf + ((ci - 1) & 1) * (TB * 256) + j * 16);
                const f32x4 s4 = (yp[0] + yp[1]) + (yp[2] + yp[3]);
                yout[(size_t)((ci - 1) * TB + (j >> 4)) * 512 + (j & 15)] = (s4[0] + s4[1]) + (s4[2] + s4[3]); }
            LDS_WAIT(); __builtin_amdgcn_s_barrier(); asm volatile("" ::: "memory");
        }
        { const LAS f32x4* yp = (const LAS f32x4*)(ybuf + ((NCH - 1) & 1) * (TB * 256) + j * 16);
          const f32x4 s4 = (yp[0] + yp[1]) + (yp[2] + yp[3]);
          yout[(size_t)((NCH - 1) * TB + (j >> 4)) * 512 + (j & 15)] = (s4[0] + s4[1]) + (s4[2] + s4[3]); }
    } else {
        const int r = F.lane >> 4, g = F.lane & 15, vrow = q * 16 + F.wave * 4 + r;
        const float m0 = g == 0 ? 1.0f : 0.0f;
        f32x2 S01 = (f32x2){0.f, 0.f}, S23 = (f32x2){0.f, 0.f};
        const unsigned lbase = (unsigned)(uintptr_t)buf;
        LDS_WAIT(); __builtin_amdgcn_s_barrier(); asm volatile("" ::: "memory");
#define RW_LD(R, st_) do { \
            asm volatile("ds_read_b128 %0, %1 offset:%2" : "=v"(R##nk) : "v"(ak), "i"((st_) * RECF * 4) : "memory"); \
            asm volatile("ds_read_b128 %0, %1 offset:%2" : "=v"(R##be) : "v"(ak), "i"((st_) * RECF * 4 + 256) : "memory"); \
            asm volatile("ds_read_b128 %0, %1 offset:%2" : "=v"(R##dd) : "v"(ak), "i"((st_) * RECF * 4 + 512) : "memory"); \
            asm volatile("ds_read_b128 %0, %1 offset:%2" : "=v"(R##kp) : "v"(ak), "i"((st_) * RECF * 4 + 768) : "memory"); \
            asm volatile("ds_read_b128 %0, %1 offset:%2" : "=v"(R##dr) : "v"(ak), "i"((st_) * RECF * 4 + 1024) : "memory"); \
            asm volatile("ds_read_b32 %0, %1 offset:%2" : "=v"(R##vv) : "v"(av), "i"((st_) * RECF * 4) : "memory"); \
            asm volatile("ds_read_b64 %0, %1 offset:%2" : "=v"(R##cc) : "v"(ac), "i"((st_) * RECF * 4) : "memory"); } while (0)
#define RW_WAIT(R) asm volatile("s_waitcnt lgkmcnt(0)" : "+v"(R##nk), "+v"(R##be), "+v"(R##dd), "+v"(R##kp), "+v"(R##dr), "+v"(R##vv), "+v"(R##cc) :: "memory")
#define RW_STEP(C, N, st_) do { \
            RW_WAIT(C); \
            if ((st_) + 1 < TB) RW_LD(N, (st_) + 1 < TB ? (st_) + 1 : 0); \
            f32x2 t = S01 * (f32x2){C##nk[0], C##nk[1]}; t = S23 * (f32x2){C##nk[2], C##nk[3]} + t; \
            f32x2 u = S01 * (f32x2){C##dr[0], C##dr[1]}; u = S23 * (f32x2){C##dr[2], C##dr[3]} + u; \
            const float sa = allreduce16(t[0] + t[1]); \
            const f32x2 w01 = (f32x2){C##be[0], C##be[1]} * sa + (f32x2){C##kp[0], C##kp[1]} * C##vv, w23 = (f32x2){C##be[2], C##be[3]} * sa + (f32x2){C##kp[2], C##kp[3]} * C##vv; \
            S01 = S01 * (f32x2){C##dd[0], C##dd[1]} + w01; S23 = S23 * (f32x2){C##dd[2], C##dd[3]} + w23; \
            yb[(st_) * 256] = (u[0] + u[1]) + m0 * (sa * C##cc[0] + C##vv * C##cc[1]); } while (0)
        for (int ci = 0; ci < NCH; ++ci) {
            const unsigned cb = lbase + (unsigned)((ci & 1) * BUFF * 4);
            const unsigned ak = cb + 16u * g, av = cb + (320u + vrow) * 4u, ac = cb + 384u * 4u;
            LAS float* yb = ybuf + (ci & 1) * (TB * 256) + F.wave * 64 + F.lane;
            f32x4 A_nk, A_be, A_dd, A_kp, A_dr, B_nk, B_be, B_dd, B_kp, B_dr; float A_vv, B_vv; f32x2 A_cc, B_cc;
            RW_LD(A_, 0);
            RW_STEP(A_, B_, 0); RW_STEP(B_, A_, 1); RW_STEP(A_, B_, 2); RW_STEP(B_, A_, 3); RW_STEP(A_, B_, 4); RW_STEP(B_, A_, 5); RW_STEP(A_, B_, 6); RW_STEP(B_, A_, 7);
            RW_STEP(A_, B_, 8); RW_STEP(B_, A_, 9); RW_STEP(A_, B_, 10); RW_STEP(B_, A_, 11); RW_STEP(A_, B_, 12); RW_STEP(B_, A_, 13); RW_STEP(A_, B_, 14); RW_STEP(B_, A_, 15);
            LDS_WAIT(); __builtin_amdgcn_s_barrier(); asm volatile("" ::: "memory");
        }
#undef RW_LD
#undef RW_WAIT
#undef RW_STEP
    }
}
__device__ __forceinline__ void phase_rwkv_post(const Ctx& F, int l) {
    const float* yr = wsp<float>(F, WS_YR); const float* rec = wsp<float>(F, WS_REC); const float* gv = wsp<float>(F, WS_GV); const float* bon = wsp<float>(F, SM_BON);
    const float* gng = F.in[19] + l * 512; const float* gnb = F.in[20] + l * 512; bf16_t* mixed = wsp<bf16_t>(F, WS_MIXED);
    for (int item = F.gw; item < T_TOK * 8; item += F.ngw) {
        const int t = item >> 3, h = item & 7, c = h * 64 + F.lane, s = t & (SEQ - 1), bh = (t >> 11) * 8 + h;
        const float y = yr[(size_t)t * 512 + c];
        const float mean = wave_sum(y) * (1.0f / 64.0f); const float dv = y - mean;
        const float var = wave_sum(dv * dv) * (1.0f / 64.0f);
        const float yn = dv * (1.0f / sqrtf(var + 64e-5f)) * gng[c] + gnb[c];
        const float v = rec[((size_t)bh * SEQ + s) * RECF + 320 + F.lane];
        const float o = (yn + bon[t * 8 + h] * v) * gv[(size_t)t * 512 + c];
        mixed[(size_t)t * DM + 512 + c] = (bf16_t)f2bf(o);
    }
}

__device__ __forceinline__ void conv8(const bf16_t* proj, int t, int sabs, int col, const float* cw, const float* cb, float (&o)[2][8]) {
    float x[5][8];
#pragma unroll
    for (int i = 0; i < 5; ++i) { const int sa = sabs - 3 + i; u32x4 w = (u32x4){0u, 0u, 0u, 0u}; if (sa >= 0) w = *(const u32x4*)(proj + (size_t)(t - 3 + i) * NPROJ + col);
#pragma unroll
        for (int j = 0; j < 4; ++j) { x[i][2 * j] = bflo(w[j]); x[i][2 * j + 1] = bfhi(w[j]); } }
#pragma unroll
    for (int e = 0; e < 8; ++e) { const float w0 = cw[0 * 1024 + col + e], w1 = cw[1 * 1024 + col + e], w2 = cw[2 * 1024 + col + e], w3 = cw[3 * 1024 + col + e], bb = cb[col + e];
#pragma unroll
        for (int rr = 0; rr < 2; ++rr) { const float a = x[rr][e] * w0 + x[rr + 1][e] * w1 + x[rr + 2][e] * w2 + x[rr + 3][e] * w3 + bb; o[rr][e] = a * sigmoidf_(a); } }
}
__device__ __forceinline__ void phase_mlstm_prep(const Ctx& F, int l) {
    const bf16_t* proj = wsp<bf16_t>(F, WS_PROJ); const float* gates = wsp<float>(F, SM_GATES);
    bf16_t* qc = wsp<bf16_t>(F, WS_QC); bf16_t* kc = wsp<bf16_t>(F, WS_KC);
    float* bcum = wsp<float>(F, SM_BCUM); float* iga = wsp<float>(F, SM_IGA); float* mloc = wsp<float>(F, SM_MLOC); float* blast = wsp<float>(F, SM_BLAST);
    float* cloc = wsp<float>(F, WS_CLOC); float* nloc = wsp<float>(F, SM_NLOC);
    const float* cw = F.in[5] + (size_t)l * 4 * 1024; const float* cb = F.in[6] + (size_t)l * 1024; const float* igb = F.in[7] + l * 4; const float* fgb = F.in[8] + l * 4;
    LAS bf16_t* KT = (LAS bf16_t*)F.lds;
    LAS bf16_t* VT = (LAS bf16_t*)(F.lds + 18432);
    LAS float* wsrc = (LAS float*)(F.lds + 36864);
    for (int u = F.blk; u < 1024; u += F.G) {
        const int bh = u >> 5, c = u & 31, b = bh >> 2, h = bh & 3, t0 = b * SEQ + c * 64;
        if (F.wave == 0) {
            const int t = t0 + F.lane;
            const float ig = gates[(size_t)t * 8 + h] + igb[h]; const float f = gates[(size_t)t * 8 + 4 + h] + fgb[h];
            float x = -softplusf_(-f);
#pragma unroll
            for (int o = 1; o < 64; o <<= 1) { const float y = __shfl_up(x, o); if (F.lane >= o) x += y; }
            const float bl = __shfl(x, 63); const float src = bl - x + ig; const float ml = wave_max(src);
            wsrc[F.lane] = __expf(src - ml); bcum[(size_t)t * 4 + h] = x; iga[(size_t)t * 4 + h] = ig;
            if (F.lane == 0) { mloc[u] = ml; blast[u] = bl; }
        }
        __syncthreads();
        {
            const int jj = (F.tid & 15) * 8, s0 = (F.tid >> 4) * 2, t = t0 + s0, sabs = c * 64 + s0;
            float o[2][8];
            conv8(proj, t, sabs, h * 128 + jj, cw, cb, o);
#pragma unroll
            for (int rr = 0; rr < 2; ++rr) { u32x4 w; w.x = pk2(o[rr][0], o[rr][1]); w.y = pk2(o[rr][2], o[rr][3]); w.z = pk2(o[rr][4], o[rr][5]); w.w = pk2(o[rr][6], o[rr][7]);
                *(u32x4*)(qc + (size_t)(t + rr) * 512 + h * 128 + jj) = w; }
            conv8(proj, t, sabs, 512 + h * 128 + jj, cw, cb, o);
#pragma unroll
            for (int rr = 0; rr < 2; ++rr) { unsigned kb[8];
#pragma unroll
                for (int e = 0; e < 8; ++e) { kb[e] = f2bf(o[rr][e] * 0.08838834764831845f); KT[(jj + e) * 72 + s0 + rr] = (bf16_t)kb[e]; }
                u32x4 w; w.x = kb[0] | (kb[1] << 16); w.y = kb[2] | (kb[3] << 16); w.z = kb[4] | (kb[5] << 16); w.w = kb[6] | (kb[7] << 16);
                *(u32x4*)(kc + (size_t)(t + rr) * 512 + h * 128 + jj) = w; }
#pragma unroll
            for (int rr = 0; rr < 2; ++rr) { const u32x4 w = *(const u32x4*)(proj + (size_t)(t + rr) * NPROJ + 1024 + h * 128 + jj); const float ws = wsrc[s0 + rr];
#pragma unroll
                for (int j = 0; j < 4; ++j) { VT[(jj + 2 * j) * 72 + s0 + rr] = (bf16_t)f2bf(bflo(w[j]) * ws); VT[(jj + 2 * j + 1) * 72 + s0 + rr] = (bf16_t)f2bf(bfhi(w[j]) * ws); } }
        }
        __syncthreads();
        {
            const int fr = F.lane & 15, fq = F.lane >> 4;
            bf16x8 a[2];
#pragma unroll
            for (int ks = 0; ks < 2; ++ks) a[ks] = *(const LAS bf16x8*)(VT + (16 * F.wave + fr) * 72 + 32 * ks + 8 * fq);
            float* cbase = cloc + (size_t)u * 16384;
#pragma unroll
            for (int nt = 0; nt < 8; ++nt) {
                f32x4 acc = (f32x4){0.f, 0.f, 0.f, 0.f};
#pragma unroll
                for (int ks = 0; ks < 2; ++ks) { const bf16x8 bb = *(const LAS bf16x8*)(KT + (16 * nt + fr) * 72 + 32 * ks + 8 * fq); acc = __builtin_amdgcn_mfma_f32_16x16x32_bf16(a[ks], bb, acc, 0, 0, 0); }
#pragma unroll
                for (int rg = 0; rg < 4; ++rg) cbase[(16 * F.wave + 4 * fq + rg) * 128 + 16 * nt + fr] = acc[rg];
            }
            if (F.tid < 128) { float s = 0.f;
#pragma unroll 8
                for (int ss = 0; ss < 64; ++ss) s += wsrc[ss] * bf2f(KT[F.tid * 72 + ss]);
                nloc[(size_t)u * 128 + F.tid] = s; }
        }
        __syncthreads();
    }
}
__device__ __forceinline__ void phase_mlstm_scan(const Ctx& F) {
    const float* mloc = wsp<float>(F, SM_MLOC); const float* blast = wsp<float>(F, SM_BLAST); float* mprev = wsp<float>(F, SM_MPREV);
    const float* cloc = wsp<float>(F, WS_CLOC); const float* nloc = wsp<float>(F, SM_NLOC); bf16_t* cprev = wsp<bf16_t>(F, WS_CPREV);
    const int gt = F.blk * NTHREADS + F.tid, ngt = F.G * NTHREADS;
    for (int i = gt; i < 32 * 4096; i += ngt) {
        const int bh = i >> 12, q = i & 4095, e4 = q * 4;
        f32x4 C = (f32x4){0.f, 0.f, 0.f, 0.f}, nn = (f32x4){0.f, 0.f, 0.f, 0.f}; float m = 0.f;
        for (int c = 0; c < 32; ++c) {
            const int u = bh * 32 + c; bf16_t* cp = cprev + (size_t)u * 144 * 128;
            { u32x2 w; w.x = pk2(C[0], C[1]); w.y = pk2(C[2], C[3]); *(u32x2*)(cp + e4) = w; }
            if (q < 32) { u32x2 w; w.x = pk2(nn[0], nn[1]); w.y = pk2(nn[2], nn[3]); *(u32x2*)(cp + 128 * 128 + 4 * q) = w; }
            else if (q < 32 + 240) { *(u32x4*)(cp + 129 * 128 + (q - 32) * 8) = (u32x4){0u, 0u, 0u, 0u}; }
            if (q == 0) mprev[u] = m;
            const float bl = blast[u], ml = mloc[u];
            const float mn = fmaxf(bl + m, ml), a = __expf(bl + m - mn), cc = __expf(ml - mn);
            C = C * a + *(const f32x4*)(cloc + (size_t)u * 16384 + e4) * cc;
            if (q < 32) nn = nn * a + *(const f32x4*)(nloc + (size_t)u * 128 + 4 * q) * cc;
            m = mn;
        }
    }
}
__device__ __forceinline__ void phase_mlstm_out(const Ctx& F, int l, int first, int stride) {
    const bf16_t* proj = wsp<bf16_t>(F, WS_PROJ); const bf16_t* qc = wsp<bf16_t>(F, WS_QC); const bf16_t* kc = wsp<bf16_t>(F, WS_KC);
    const float* bcum = wsp<float>(F, SM_BCUM); const float* iga = wsp<float>(F, SM_IGA); const float* mprev = wsp<float>(F, SM_MPREV);
    const bf16_t* cprev = wsp<bf16_t>(F, WS_CPREV); bf16_t* mixed = wsp<bf16_t>(F, WS_MIXED); const float* ng = F.in[9] + l * 512;
    LAS bf16_t* VT = (LAS bf16_t*)F.lds;
    LAS bf16_t* PM = (LAS bf16_t*)(F.lds + 20736);
    LAS float* sc = (LAS float*)(F.lds + 20736 + 9216);
    const int fr = F.lane & 15, fq = F.lane >> 4;
    for (int u = first; u < 1024; u += stride) {
        const int bh = u >> 5, c = u & 31, b = bh >> 2, h = bh & 3, t0 = b * SEQ + c * 64;
        if (F.wave == 0) {
            const int t = t0 + F.lane; const float bb = bcum[(size_t)t * 4 + h], ig = iga[(size_t)t * 4 + h], mp = mprev[u];
            const float gqv = ig - bb; float pm = gqv;
#pragma unroll
            for (int o = 1; o < 64; o <<= 1) { const float y = __shfl_up(pm, o); if (F.lane >= o) pm = fmaxf(pm, y); }
            const float mt = bb + fmaxf(mp, pm);
            sc[F.lane] = bb - mt; sc[64 + F.lane] = gqv; sc[128 + F.lane] = __expf(bb + mp - mt); sc[192 + F.lane] = __expf(-mt);
        }
        {
            const int jj = (F.tid & 15) * 8, s0 = (F.tid >> 4) * 2;
#pragma unroll
            for (int rr = 0; rr < 2; ++rr) { const u32x4 w = *(const u32x4*)(proj + (size_t)(t0 + s0 + rr) * NPROJ + 1024 + h * 128 + jj);
#pragma unroll
                for (int j = 0; j < 4; ++j) { VT[(jj + 2 * j) * 72 + s0 + rr] = (bf16_t)(w[j] & 0xffffu); VT[(jj + 2 * j + 1) * 72 + s0 + rr] = (bf16_t)(w[j] >> 16); } }
            for (int i = F.tid; i < 16 * 64; i += NTHREADS) { const int rrow = i >> 6, cc = i & 63; VT[(128 + rrow) * 72 + cc] = rrow == 0 ? (bf16_t)0x3F80 : (bf16_t)0; }
        }
        __syncthreads();
        const int tt = F.wave & 3, hf = F.wave >> 2;
        bf16x8 qa[4];
#pragma unroll
        for (int ks = 0; ks < 4; ++ks) qa[ks] = *(const bf16x8*)(qc + (size_t)(t0 + 16 * tt + fr) * 512 + h * 128 + 32 * ks + 8 * fq);
        {
            const int trow = 16 * tt + fr; const float re = sc[trow];
#pragma unroll
            for (int si = 0; si < 2; ++si) { const int st = 2 * hf + si; f32x4 acc = (f32x4){0.f, 0.f, 0.f, 0.f};
#pragma unroll
                for (int ks = 0; ks < 4; ++ks) { const bf16x8 kb = *(const bf16x8*)(kc + (size_t)(t0 + 16 * st + fr) * 512 + h * 128 + 32 * ks + 8 * fq);
                    acc = __builtin_amdgcn_mfma_f32_16x16x32_bf16(kb, qa[ks], acc, 0, 0, 0); }
                float pv[4];
#pragma unroll
                for (int j = 0; j < 4; ++j) { const int s = 16 * st + 4 * fq + j; const float e = __expf(re + sc[64 + s]); pv[j] = (s <= trow) ? acc[j] * e : 0.f; }
                u32x2 w; w.x = pk2(pv[0], pv[1]); w.y = pk2(pv[2], pv[3]); *(LAS u32x2*)(PM + trow * 72 + 16 * st + 4 * fq) = w; }
        }
        __syncthreads();
        {
            const int trow = 16 * tt + fr, t = t0 + trow; const float wi = sc[128 + trow], enm = sc[192 + trow];
            bf16x8 pa[2];
#pragma unroll
            for (int ks = 0; ks < 2; ++ks) pa[ks] = *(const LAS bf16x8*)(PM + trow * 72 + 32 * ks + 8 * fq);
            const bf16_t* cp = cprev + (size_t)u * 144 * 128;
            f32x4 num[5];
#pragma unroll
            for (int ci = 0; ci < 5; ++ci) { const int ct = ci < 4 ? 4 * hf + ci : 8;
                f32x4 apv = (f32x4){0.f, 0.f, 0.f, 0.f}, ain = (f32x4){0.f, 0.f, 0.f, 0.f};
#pragma unroll
                for (int ks = 0; ks < 2; ++ks) { const bf16x8 vb = *(const LAS bf16x8*)(VT + (16 * ct + fr) * 72 + 32 * ks + 8 * fq); apv = __builtin_amdgcn_mfma_f32_16x16x32_bf16(vb, pa[ks], apv, 0, 0, 0); }
#pragma unroll
                for (int ks = 0; ks < 4; ++ks) { const bf16x8 cb = *(const bf16x8*)(cp + (size_t)(16 * ct + fr) * 128 + 32 * ks + 8 * fq); ain = __builtin_amdgcn_mfma_f32_16x16x32_bf16(cb, qa[ks], ain, 0, 0, 0); }
                num[ci] = apv + ain * wi; }
            const float den = __shfl(num[4][0], fr);
            const float dn = 1.0f / fmaxf(fabsf(den), enm);
            float s1 = 0.f;
#pragma unroll
            for (int ci = 0; ci < 4; ++ci) { num[ci] = num[ci] * dn; s1 += (num[ci][0] + num[ci][1]) + (num[ci][2] + num[ci][3]); }
            s1 += __shfl_xor(s1, 16); s1 += __shfl_xor(s1, 32);
            if (fq == 0) sc[256 + trow * 2 + hf] = s1;
            __syncthreads();
            const float mean = (sc[256 + trow * 2] + sc[256 + trow * 2 + 1]) * (1.0f / 128.0f);
            float s2 = 0.f;
#pragma unroll
            for (int ci = 0; ci < 4; ++ci) { num[ci] = num[ci] - mean; s2 += (num[ci][0] * num[ci][0] + num[ci][1] * num[ci][1]) + (num[ci][2] * num[ci][2] + num[ci][3] * num[ci][3]); }
            s2 += __shfl_xor(s2, 16); s2 += __shfl_xor(s2, 32);
            if (fq == 0) sc[384 + trow * 2 + hf] = s2;
            __syncthreads();
            const float rstd = 1.0f / sqrtf((sc[384 + trow * 2] + sc[384 + trow * 2 + 1]) * (1.0f / 128.0f) + 1e-5f);
#pragma unroll
            for (int ci = 0; ci < 4; ++ci) { const int col = h * 128 + 16 * (4 * hf + ci) + 4 * fq;
                const u32x2 mo = *(const u32x2*)(proj + (size_t)t * NPROJ + 1536 + col); const f32x4 gg = *(const f32x4*)(ng + col);
                const float o0 = num[ci][0] * rstd * gg[0] * sigmoidf_(bflo(mo.x)), o1 = num[ci][1] * rstd * gg[1] * sigmoidf_(bfhi(mo.x));
                const float o2 = num[ci][2] * rstd * gg[2] * sigmoidf_(bflo(mo.y)), o3 = num[ci][3] * rstd * gg[3] * sigmoidf_(bfhi(mo.y));
                u32x2 w; w.x = pk2(o0, o1); w.y = pk2(o2, o3); *(u32x2*)(mixed + (size_t)t * DM + col) = w; }
        }
        __syncthreads();
    }
}

__device__ __forceinline__ void phase_router(const Ctx& F, int l) {
    LAS float* W = (LAS float*)F.lds;
    LAS float* lg = (LAS float*)(F.lds + MISC_OFF);
    LAS unsigned* hist = (LAS unsigned*)(F.lds + MISC_OFF + 2048);
    const float* wr = F.in[29] + (size_t)l * 1024 * 32; const float* br = F.in[30] + l * 32;
    const float* H = wsp<float>(F, WS_H); int* topi = wsp<int>(F, SM_TOPI); float* topg = wsp<float>(F, SM_TOPG); unsigned* ctl = wsp<unsigned>(F, WS_CTL);
    for (int i = F.tid; i < 8192; i += NTHREADS) ((LAS f32x4*)W)[i] = ((const f32x4*)wr)[i];
    if (F.tid < 32) hist[F.tid] = 0u;
    __syncthreads();
    const int r = F.tid >> 5, e = F.tid & 31;
    for (int base = F.blk * 16; base < T_TOK; base += F.G * 16) {
        const int t = base + r; const float* hr = H + (size_t)t * DM;
        float a0 = br[e], a1 = 0.f, a2 = 0.f, a3 = 0.f;
#pragma unroll 4
        for (int d4 = 0; d4 < 256; ++d4) { const f32x4 hv = *(const f32x4*)(hr + 4 * d4); const LAS float* wp = W + (4 * d4) * 32 + e;
            a0 += hv[0] * wp[0]; a1 += hv[1] * wp[32]; a2 += hv[2] * wp[64]; a3 += hv[3] * wp[96]; }
        lg[r * 32 + e] = (a0 + a1) + (a2 + a3);
        __syncthreads();
        if (e == 0) {
            float v[4]; int id[4]; unsigned used = 0u;
#pragma unroll
            for (int k = 0; k < 4; ++k) { float best = -3.0e38f; int bi = 0;
                for (int j = 0; j < 32; ++j) { const float x = lg[r * 32 + j]; if (!((used >> j) & 1u) && x > best) { best = x; bi = j; } }
                used |= 1u << bi; v[k] = best; id[k] = bi; }
            const float e1 = __expf(v[1] - v[0]), e2 = __expf(v[2] - v[0]), e3 = __expf(v[3] - v[0]); const float inv = 1.0f / (1.0f + e1 + e2 + e3);
            topi[t * 4 + 0] = id[0]; topi[t * 4 + 1] = id[1]; topi[t * 4 + 2] = id[2]; topi[t * 4 + 3] = id[3];
            topg[t * 4 + 0] = inv; topg[t * 4 + 1] = e1 * inv; topg[t * 4 + 2] = e2 * inv; topg[t * 4 + 3] = e3 * inv;
#pragma unroll
            for (int k = 0; k < 4; ++k) atomicAdd((unsigned*)&hist[id[k]], 1u);
        }
        __syncthreads();
    }
    if (F.tid < 32 && hist[F.tid]) atomicAdd(&ctl[CW_CNT + l * 32 + F.tid], hist[F.tid]);
}
__device__ __forceinline__ void phase_slots(const Ctx& F, int l) {
    LAS unsigned* lc = (LAS unsigned*)F.lds; LAS unsigned* lbase = lc + 32; LAS unsigned* pst = lc + 64; LAS int* aslot = (LAS int*)(lc + 128); LAS int* atok = aslot + 256;
    unsigned* ctl = wsp<unsigned>(F, WS_CTL); const int* topi = wsp<int>(F, SM_TOPI); int* slotp = wsp<int>(F, SM_SLOT);
    const bf16_t* HB = wsp<bf16_t>(F, WS_HB); bf16_t* XG = wsp<bf16_t>(F, WS_XG);
    if (F.tid < 32) lc[F.tid] = 0u;
    if (F.tid == 0) { unsigned acc = 0u;
        for (int e = 0; e < 32; ++e) { pst[e] = acc; const unsigned c = ctl[CW_CNT + l * 32 + e]; acc += ((c + 255u) >> 8) << 8; }
        pst[32] = acc;
        if (F.blk == 0) for (int e = 0; e <= 32; ++e) ctl[CW_TILE + l * 40 + e] = pst[e] >> 8; }
    __syncthreads();
    for (int tb = F.blk; tb < T_TOK / 64; tb += F.G) {
        int myE = 0, myRank = 0, t = 0, k = 0;
        if (F.tid < 256) { t = tb * 64 + (F.tid >> 2); k = F.tid & 3; myE = topi[t * 4 + k]; myRank = (int)atomicAdd((unsigned*)&lc[myE], 1u); }
        __syncthreads();
        if (F.tid < 32) lbase[F.tid] = lc[F.tid] ? atomicAdd(&ctl[CW_CUR + l * 32 + F.tid], lc[F.tid]) : 0u;
        __syncthreads();
        if (F.tid < 256) { const int sl = (int)(pst[myE] + lbase[myE]) + myRank; slotp[t * 4 + k] = sl; aslot[F.tid] = sl; atok[F.tid] = t; }
        __syncthreads();
        if (F.tid < 32) lc[F.tid] = 0u;
        for (int a = 0; a < 32; ++a) { const int idx = F.wave * 32 + a; const int sl = aslot[idx], tk = atok[idx];
            const u32x4* src = (const u32x4*)(HB + (size_t)tk * DM); u32x4* dst = (u32x4*)(XG + (size_t)sl * DM);
            dst[F.lane] = src[F.lane]; dst[64 + F.lane] = src[64 + F.lane]; }
        __syncthreads();
    }
}

__device__ __forceinline__ const void* launder(const void* p) {
    unsigned long long x = (unsigned long long)p; unsigned lo = (unsigned)x, hi = (unsigned)(x >> 32);
    asm volatile("" : "+v"(lo), "+v"(hi));
    lo = __builtin_amdgcn_readfirstlane(lo); hi = __builtin_amdgcn_readfirstlane(hi);
    return (const void*)(((unsigned long long)hi << 32) | lo);
}
__device__ __forceinline__ void moe_build_units(const Ctx& F, int l, int npn) {
    LAS int* ul = (LAS int*)(F.lds + MISC_OFF + 4096);
    const unsigned* ts = wsp<unsigned>(F, WS_CTL) + CW_TILE + l * 40;
    if (F.tid < 16) {
        const int NT = (int)ts[32]; const long L = (long)F.tid * F.G + F.blk; int pm = -1, pn = 0, e = 0;
        if (L < (long)NT * npn) { pm = (int)(L / npn); pn = (int)(L % npn); for (int j = 1; j < 32; ++j) e += ((int)ts[j] <= pm) ? 1 : 0; }
        ul[3 * F.tid] = pm; ul[3 * F.tid + 1] = pn; ul[3 * F.tid + 2] = e;
    }
    __syncthreads();
}

#define XB_TMO      128
#define XB_XCNT(j)  (256  + 64 * (j))
#define XB_XSUB(j)  (1280 + 64 * (j))
#define XB_XGEN(j)  (2304 + 64 * (j))
#define XB_TOP      3328
#define XB_TOPGEN   3392
#define XCD_BAR_WORDS 3456
#define XB_SPIN_CAP (1u << 22)
constexpr int CW_BAR = 1024;
__device__ __forceinline__ unsigned xb_ld(unsigned* p)              { return __hip_atomic_load(p, __ATOMIC_RELAXED, __HIP_MEMORY_SCOPE_AGENT); }
__device__ __forceinline__ unsigned xb_add(unsigned* p, unsigned v) { return __hip_atomic_fetch_add(p, v, __ATOMIC_RELAXED, __HIP_MEMORY_SCOPE_AGENT); }
__device__ __forceinline__ unsigned xb_xcc_id() { return (unsigned)__builtin_amdgcn_s_getreg((3 << 11) | 20) & 0xFu; }
#define XB_SPIN(cond, bar) do { unsigned _sp = 0; while (cond) { __builtin_amdgcn_s_sleep(1); \
    if ((++_sp & 255u) == 0u) { if (xb_ld(&(bar)[XB_TMO])) break; if (_sp > XB_SPIN_CAP) { atomicAdd(&(bar)[XB_TMO], 1u); break; } } } } while (0)
struct XcdBarrier { unsigned* bar; unsigned x; volatile LAS unsigned* st; };
__device__ __forceinline__ XcdBarrier xcd_barrier_post(unsigned* bar, volatile LAS unsigned* st) {
    XcdBarrier b; b.bar = bar; b.x = xb_xcc_id(); b.st = st;
    if (threadIdx.x == 0) (void)xb_add(&bar[XB_XCNT(b.x)], 1u);
    return b;
}
__device__ __forceinline__ void xcd_barrier_complete(unsigned* bar, unsigned x, unsigned& nloc, unsigned& nx) {
    const unsigned G = gridDim.x * gridDim.y * gridDim.z;
    unsigned sum, cnt, mine, sp = 0u;
    for (;;) {
        sum = 0u; cnt = 0u; mine = 0u;
#pragma unroll
        for (unsigned j = 0; j < 16; ++j) { const unsigned c = xb_ld(&bar[XB_XCNT(j)]); sum += c; cnt += (c > 0u) ? 1u : 0u; mine = (j == x) ? c : mine; }
        if (sum == G) break;
        __builtin_amdgcn_s_sleep(1);
        if ((++sp & 255u) == 0u) { if (xb_ld(&bar[XB_TMO])) break; if (sp > XB_SPIN_CAP) { atomicAdd(&bar[XB_TMO], 1u); break; } }
    }
    nloc = mine > 0u ? mine : 1u; nx = cnt > 0u ? cnt : 1u;
}
__device__ __forceinline__ void xcd_barrier(const XcdBarrier& b) {
    asm volatile("s_waitcnt vmcnt(0)" ::: "memory");
    __syncthreads();
    if (threadIdx.x == 0) {
        unsigned* bar = b.bar;
        __builtin_amdgcn_s_waitcnt(0);
        unsigned nloc = b.st[0], nx = b.st[1];
        if (nloc == 0u) { xcd_barrier_complete(bar, b.x, nloc, nx); b.st[0] = nloc; b.st[1] = nx; }
        const unsigned old = xb_add(&bar[XB_XSUB(b.x)], 1u);
        const unsigned gen = old / nloc;
        if (old + 1u == (gen + 1u) * nloc) {
            __builtin_amdgcn_fence(__ATOMIC_RELEASE, "agent");
            asm volatile("s_waitcnt vmcnt(0)" ::: "memory");
            const unsigned og = xb_add(&bar[XB_TOP], 1u);
            const unsigned tg = og / nx;
            if (og + 1u == (tg + 1u) * nx) xb_add(&bar[XB_TOPGEN], 1u);
            else XB_SPIN(xb_ld(&bar[XB_TOPGEN]) == tg, bar);
            __builtin_amdgcn_fence(__ATOMIC_ACQUIRE, "agent");
            xb_add(&bar[XB_XGEN(b.x)], 1u);
            asm volatile("s_waitcnt vmcnt(0)" ::: "memory");
        } else {
            XB_SPIN(xb_ld(&bar[XB_XGEN(b.x)]) == gen, bar);
            __builtin_amdgcn_fence(__ATOMIC_ACQUIRE, "agent");
            asm volatile("s_waitcnt vmcnt(0)" ::: "memory");
        }
    }
    __syncthreads();
}
constexpr int PH_PER_LAYER = 18, NPHASES = 2 + DEPTH * PH_PER_LAYER;
__global__ void __launch_bounds__(NTHREADS, 2) mk_fwd(Args args) {
    extern __shared__ __attribute__((aligned(16))) unsigned char lds_raw[];
    Ctx F; F.lds = (LAS unsigned char*)lds_raw; F.tid = threadIdx.x; F.lane = F.tid & 63; F.wave = __builtin_amdgcn_readfirstlane(F.tid >> 6);
    F.blk = blockIdx.x; F.G = gridDim.x; F.gw = F.blk * NWAVES + F.wave; F.ngw = F.G * NWAVES;
    {   LAS unsigned long long* tab = (LAS unsigned long long*)(F.lds + TAB_OFF);
        if (F.tid == 0) {
#define TB_(k) tab[k] = (unsigned long long)args.in[k];
            TB_(0) TB_(1) TB_(2) TB_(3) TB_(4) TB_(5) TB_(6) TB_(7) TB_(8) TB_(9) TB_(10) TB_(11) TB_(12) TB_(13) TB_(14) TB_(15) TB_(16) TB_(17) TB_(18)
            TB_(19) TB_(20) TB_(21) TB_(22) TB_(23) TB_(24) TB_(25) TB_(26) TB_(27) TB_(28) TB_(29) TB_(30) TB_(31) TB_(32) TB_(33) TB_(34) TB_(35) TB_(36)
#undef TB_
            tab[37] = (unsigned long long)args.out; tab[38] = (unsigned long long)args.ws;
            ((LAS unsigned*)(F.lds + TAB_OFF + 512))[0] = 0u; ((LAS unsigned*)(F.lds + TAB_OFF + 512))[1] = 0u; }
        __syncthreads();
        F.in.t = (LAS const volatile unsigned*)(F.lds + TAB_OFF); F.out = nullptr; F.wsi = 0ull; }
    const int lo = args.ph_lo, hi = args.ph_hi;
    XcdBarrier xbar = xcd_barrier_post((unsigned*)(args.ws + WS_CTL) + CW_BAR, (volatile LAS unsigned*)(F.lds + TAB_OFF + 512));
#if ONE_LAUNCH
    cg::grid_group grid = cg::this_grid();
#define SEAM(k) do { if ((k) + 1 < hi) { if ((k) == 0) grid.sync(); else xcd_barrier(xbar); } } while (0)
#else
#define SEAM(k) do { } while (0)
#endif
#ifndef PHMASK
#define PHMASK 0xFFFFFu
#endif
#define IN(k) (lo <= (k) && (k) < hi)
#define ON(r) (((PHMASK) >> (r)) & 1u)
#define REPEAT(r) for (int rep_ = 0; rep_ < (((r) == PROBE_PH) ? 1 + PROBE_N : 1); ++rep_)
#define FRESH() do { int _t = threadIdx.x; int _b = blockIdx.x, _g = gridDim.x; unsigned _l = (unsigned)(uintptr_t)(LAS unsigned char*)lds_raw; asm volatile("" : "+v"(_t), "+s"(_b), "+s"(_g), "+s"(_l)); F.tid = _t; F.lane = _t & 63; F.wave = __builtin_amdgcn_readfirstlane(_t >> 6); F.blk = _b; F.G = _g; F.gw = _b * NWAVES + F.wave; F.ngw = _g * NWAVES; F.lds = (LAS unsigned char*)(uintptr_t)_l; lds = F.lds; F.in.t = (LAS const volatile unsigned*)(F.lds + TAB_OFF); F.out = (float*)(GAS float*)F.in.geti(37); F.wsi = F.in.geti(38); } while (0)
    LAS unsigned char* lds = F.lds;
    if (ON(18) && IN(0)) { FRESH(); REPEAT(18) { phase_prologue(F); __syncthreads(); __syncthreads(); } SEAM(0); }
    if (ON(19) && IN(1)) { FRESH(); REPEAT(19) {
        pg8::KvOrder S; S.memb = (const char*)wsp<bf16_t>(F, WS_MEMB); S.wkv = (const char*)wsp<bf16_t>(F, WS_WKV); S.lda = 1024; S.ldb = 1024; S.K = 1024; S.G = F.G; S.c = F.blk;
        pg8::EpiKv E{wsp<bf16_t>(F, WS_KBUF), wsp<bf16_t>(F, WS_VTB)};
        pg8::gemm_phase(lds, S, E); __syncthreads(); __syncthreads(); } SEAM(1);
    }
    for (int l = 0; l < DEPTH; ++l) {
        const int pb = 2 + l * PH_PER_LAYER;
        if (ON(0) && IN(pb + 0)) { FRESH(); REPEAT(0) {
            pg8::DenseOrder S; S.init(wsp<bf16_t>(F, WS_HB), wsp<bf16_t>(F, WS_WIN) + (size_t)l * 4096 * 1024, T_TOK, NPROJ, 1024, 1024, 1024, F.G, F.blk);
            pg8::EpiProj E{wsp<bf16_t>(F, WS_PROJ), wsp<float>(F, SM_GATES)};
            pg8::gemm_phase(lds, S, E); __syncthreads(); __syncthreads(); } SEAM(pb + 0);
        }
        if (ON(1) && IN(pb + 1)) { FRESH(); REPEAT(1) { phase_xlr(F, l); phase_mlstm_prep(F, l); __syncthreads(); __syncthreads(); } SEAM(pb + 1); }
        if (ON(2) && IN(pb + 2)) { FRESH(); REPEAT(2) {
            pg8::DenseOrder S; S.init(wsp<bf16_t>(F, WS_XLR), wsp<bf16_t>(F, WS_WLR) + (size_t)l * 1536 * 256, T_TOK, 1536, 256, 256, 256, F.G, F.blk);
            pg8::EpiF32 E{wsp<float>(F, WS_LR), 1536};
            pg8::gemm_phase(lds, S, E); __syncthreads();
            phase_mlstm_scan(F); __syncthreads(); } SEAM(pb + 2);
        }
        if (ON(3) && IN(pb + 3)) { FRESH(); REPEAT(3) { phase_rwkv_prep(F, l); __syncthreads(); phase_mlstm_out(F, l, F.blk, F.G); __syncthreads(); } SEAM(pb + 3); }
        if (ON(4) && IN(pb + 4)) { FRESH(); REPEAT(4) { phase_rwkv_scan(F); __syncthreads(); __syncthreads(); } SEAM(pb + 4); }
        if (ON(5) && IN(pb + 5)) { FRESH(); REPEAT(5) { phase_rwkv_post(F, l); __syncthreads(); } SEAM(pb + 5); }
        if (ON(6) && IN(pb + 6)) { FRESH(); REPEAT(6) {
            pg8::DenseOrder S; S.init(wsp<bf16_t>(F, WS_MIXED), wsp<bf16_t>(F, WS_WOUT) + (size_t)l * 1024 * 1024, T_TOK, 1024, 1024, 1024, 1024, F.G, F.blk);
            pg8::EpiF32 E{wsp<float>(F, WS_CF), 1024};
            pg8::gemm_phase(lds, S, E); __syncthreads(); __syncthreads(); } SEAM(pb + 6);
        }
        if (ON(7) && IN(pb + 7)) { FRESH(); REPEAT(7) { phase_ln_add(F, F.in[22] + l * 1024, F.in[23] + l * 1024); __syncthreads(); } SEAM(pb + 7); }
        if (ON(8) && IN(pb + 8)) { FRESH(); REPEAT(8) {
            pg8::DenseOrder S; S.init(wsp<bf16_t>(F, WS_HB), wsp<bf16_t>(F, WS_WQ) + (size_t)l * 1024 * 1024, T_TOK, 1024, 1024, 1024, 1024, F.G, F.blk);
            pg8::EpiBf16 E{wsp<bf16_t>(F, WS_QB), 1024, 0.0625f};
            pg8::gemm_phase(lds, S, E); __syncthreads(); __syncthreads(); } SEAM(pb + 8);
        }
        if (ON(9) && IN(pb + 9)) { FRESH(); REPEAT(9) {
            pg8::SOrder S; S.Q = (const char*)wsp<bf16_t>(F, WS_QB); S.Kb = (const char*)(wsp<bf16_t>(F, WS_KBUF) + (size_t)l * 2048 * 1024); S.lda = 1024; S.ldb = 1024; S.K = 256; S.G = F.G; S.c = F.blk;
            pg8::EpiSoftmax E{wsp<bf16_t>(F, WS_PB)};
            pg8::gemm_phase(lds, S, E); __syncthreads(); __syncthreads(); } SEAM(pb + 9);
        }
        if (ON(10) && IN(pb + 10)) { FRESH(); REPEAT(10) {
            pg8::PvOrder S; S.P = (const char*)wsp<bf16_t>(F, WS_PB); S.Vt = (const char*)(wsp<bf16_t>(F, WS_VTB) + (size_t)l * 1024 * 2048); S.lda = 256; S.ldb = 2048; S.K = 256; S.G = F.G; S.c = F.blk;
            pg8::EpiPv E{wsp<bf16_t>(F, WS_OB)};
            pg8::gemm_phase(lds, S, E); __syncthreads(); __syncthreads(); } SEAM(pb + 10);
        }
        if (ON(11) && IN(pb + 11)) { FRESH(); REPEAT(11) {
            pg8::DenseOrder S; S.init(wsp<bf16_t>(F, WS_OB), wsp<bf16_t>(F, WS_WO) + (size_t)l * 1024 * 1024, T_TOK, 1024, 1024, 1024, 1024, F.G, F.blk);
            pg8::EpiF32 E{wsp<float>(F, WS_CF), 1024};
            pg8::gemm_phase(lds, S, E); __syncthreads(); __syncthreads(); } SEAM(pb + 11);
        }
        if (ON(12) && IN(pb + 12)) { FRESH(); REPEAT(12) { phase_ln_add(F, F.in[27] + l * 1024, F.in[28] + l * 1024); __syncthreads(); } SEAM(pb + 12); }
        if (ON(13) && IN(pb + 13)) { FRESH(); REPEAT(13) { phase_router(F, l); __syncthreads(); __syncthreads(); } SEAM(pb + 13); }
        if (ON(14) && IN(pb + 14)) { FRESH(); REPEAT(14) { phase_slots(F, l); __syncthreads(); __syncthreads(); } SEAM(pb + 14); }
        if (ON(15) && IN(pb + 15)) { FRESH(); REPEAT(15) {
            moe_build_units(F, l, 8);
            pg8::MoeOrder S; S.A = (const char*)wsp<bf16_t>(F, WS_XG); S.W = (const char*)(wsp<bf16_t>(F, WS_W1) + (size_t)l * 32 * 2048 * 1024); S.ul = (LAS const int*)(F.lds + MISC_OFF + 4096);
            S.wstride = (size_t)2048 * 1024 * 2; S.lda = 1024; S.ldb = 1024; S.K = 1024;
            pg8::EpiSwiglu E{wsp<bf16_t>(F, WS_GACT), F.in[32] + (size_t)l * 32 * 2048};
            pg8::gemm_phase(lds, S, E); __syncthreads(); __syncthreads(); } SEAM(pb + 15);
        }
        if (ON(16) && IN(pb + 16)) { FRESH(); REPEAT(16) {
            moe_build_units(F, l, 4);
            pg8::MoeOrder S; S.A = (const char*)wsp<bf16_t>(F, WS_GACT); S.W = (const char*)(wsp<bf16_t>(F, WS_W2) + (size_t)l * 32 * 1024 * 1024); S.ul = (LAS const int*)(F.lds + MISC_OFF + 4096);
            S.wstride = (size_t)1024 * 1024 * 2; S.lda = 1024; S.ldb = 1024; S.K = 1024;
            pg8::EpiMoeY E{wsp<bf16_t>(F, WS_YB), F.in[34] + (size_t)l * 32 * 1024};
            pg8::gemm_phase(lds, S, E); __syncthreads(); __syncthreads(); } SEAM(pb + 16);
        }
        if (ON(17) && IN(pb + 17)) { FRESH(); REPEAT(17) { phase_ln_moe(F, F.in[35] + l * 1024, F.in[36] + l * 1024, l == DEPTH - 1); __syncthreads(); } SEAM(pb + 17); }
    }
#undef IN
#undef SEAM
}

extern "C" void kernel_launch(void* const* d_in, const int* in_sizes, int n_in, void* d_out, int out_size, void* d_ws, size_t ws_size, hipStream_t stream) {
    static int grid = 0;
    if (grid == 0) {
        if (n_in != 37 || out_size != T_TOK * DM || ws_size < WS_END) { fprintf(stderr, "kernel_launch: unexpected shapes: n_in %d out %d ws %zu (need %zu)\n", n_in, out_size, ws_size, (size_t)WS_END); grid = -1; return; }
        int dev = 0, cus = 0, per_cu = 0;
        hipGetDevice(&dev); hipDeviceGetAttribute(&cus, hipDeviceAttributeMultiprocessorCount, dev);
        if (hipFuncSetAttribute((const void*)mk_fwd, hipFuncAttributeMaxDynamicSharedMemorySize, LDS_BYTES) != hipSuccess) { fprintf(stderr, "kernel_launch: hipFuncSetAttribute failed\n"); grid = -1; return; }
        if (hipOccupancyMaxActiveBlocksPerMultiprocessor(&per_cu, (const void*)mk_fwd, NTHREADS, LDS_BYTES) != hipSuccess || per_cu < 1) { fprintf(stderr, "kernel_launch: occupancy query says %d blocks per CU\n", per_cu); (void)hipGetLastError(); per_cu = 1; }
        grid = cus;
        if (grid > 256) grid = 256;
    }
    if (grid < 0) return;
    (void)hipMemsetAsync((char*)d_ws + WS_CTL, 0, CTL_BYTES, stream);
    Args a{};
    for (int i = 0; i < 37; ++i) a.in[i] = (const float*)d_in[i];
    a.out = (float*)d_out; a.ws = (unsigned char*)d_ws;
#if ONE_LAUNCH
    a.ph_lo = 0; a.ph_hi = NPHASES;
    void* kargs[] = {&a};
    hipError_t e = hipLaunchCooperativeKernel((const void*)mk_fwd, dim3(grid), dim3(NTHREADS), kargs, LDS_BYTES, stream);
    if (e != hipSuccess) fprintf(stderr, "kernel_launch: cooperative launch failed: %s (grid %d)\n", hipGetErrorString(e), grid);
#else
    for (int ph = 0; ph < NPHASES; ++ph) { a.ph_lo = ph; a.ph_hi = ph + 1; hipLaunchKernelGGL(mk_fwd, dim3(grid), dim3(NTHREADS), LDS_BYTES, stream, a); }
#endif
}
```
